# Optimizing an MI355X kernel written in HIP

```python
import math
import jax
import jax.numpy as jnp
from jax import lax
import numpy as np


D_MODEL = 1024
BATCH = 16
SEQ = 2048
DEPTH = 2

HEAD_DIM = 64
FOX_HEADS = (D_MODEL // 2) // HEAD_DIM
DIFF_HEADS = (D_MODEL // 2) // (2 * HEAD_DIM)
SWA_HEADS = D_MODEL // HEAD_DIM
SWA_KV_HEADS = SWA_HEADS // 4
SWA_GROUP = SWA_HEADS // SWA_KV_HEADS
WINDOW = 128
Q_BLOCK = 128
NUM_BUCKETS = 32
MAX_DISTANCE = 128
REL_HEADS = max(DIFF_HEADS, SWA_HEADS)
FFN_HIDDEN = -(-8 * D_MODEL // (3 * 256)) * 256
N_EVEN = (DEPTH + 1) // 2
N_ODD = DEPTH // 2
RMS_EPS = 1e-6
NEG_INF = -1e30
FOX_W = FOX_HEADS * HEAD_DIM
DIFF_W = DIFF_HEADS * 2 * HEAD_DIM
IN_SPLITS = (FOX_W, FOX_W, FOX_W, FOX_HEADS, DIFF_W, DIFF_W, DIFF_W)
IN_SPLIT_IDX = tuple(int(i) for i in np.cumsum(IN_SPLITS)[:-1])
EVEN_IN_WIDTH = sum(IN_SPLITS)
MIX_WIDTH = FOX_W + DIFF_W
SWA_Q_W = SWA_HEADS * HEAD_DIM
SWA_KV_W = SWA_KV_HEADS * HEAD_DIM
SWA_QKV_WIDTH = SWA_Q_W + 2 * SWA_KV_W

kernel_name = 'hybrid_fox_diff_swa_block'


def rms_norm(x, gain):
    xf = x.astype(jnp.float32)
    y = xf * lax.rsqrt(jnp.mean(xf * xf, axis=-1, keepdims=True) + RMS_EPS)
    return (y * gain.astype(jnp.float32)).astype(x.dtype)


def t5_bucket(delta):
    n = jnp.maximum(delta, 0)
    max_exact = NUM_BUCKETS // 2
    nf = jnp.maximum(n, 1).astype(jnp.float32)
    large = max_exact + (jnp.log(nf / max_exact) / math.log(MAX_DISTANCE / max_exact)
                         * (NUM_BUCKETS - max_exact)).astype(jnp.int32)
    large = jnp.minimum(large, NUM_BUCKETS - 1)
    return jnp.where(n < max_exact, n, large)


def rel_bias(table, delta):
    return jnp.transpose(table[t5_bucket(delta)].astype(jnp.float32), (2, 0, 1))


def fox_attention(q, k, v, c):
    S = q.shape[1]
    scale = HEAD_DIM ** -0.5
    outs = []
    for i in range(S // Q_BLOCK):
        start, end = i * Q_BLOCK, (i + 1) * Q_BLOCK
        qpos = jnp.arange(start, end)
        kpos = jnp.arange(end)
        causal = kpos[None, :] <= qpos[:, None]
        s = jnp.einsum('bqhd,bkhd->bhqk', q[:, start:end], k[:, :end]).astype(jnp.float32) * scale
        s = s + c[:, :, start:end, None] - c[:, :, None, :end]
        p = jax.nn.softmax(jnp.where(causal, s, NEG_INF), axis=-1)
        outs.append(jnp.einsum('bhqk,bkhd->bqhd', p.astype(v.dtype), v[:, :end]))
    return jnp.concatenate(outs, axis=1)


def diff_attention(q, k, v, lam, table):
    S = q.shape[1]
    scale = HEAD_DIM ** -0.5
    outs = []
    for i in range(S // Q_BLOCK):
        start, end = i * Q_BLOCK, (i + 1) * Q_BLOCK
        qpos = jnp.arange(start, end)
        kpos = jnp.arange(end)
        delta = qpos[:, None] - kpos[None, :]
        s = jnp.einsum('bqhmd,bkhmd->bhmqk', q[:, start:end], k[:, :end]).astype(jnp.float32) * scale
        s = s + rel_bias(table, delta)[None, :, None]
        p = jax.nn.softmax(jnp.where(delta >= 0, s, NEG_INF), axis=-1)
        a = p[:, :, 0] - lam * p[:, :, 1]
        outs.append(jnp.einsum('bhqk,bkhe->bqhe', a.astype(v.dtype), v[:, :end]))
    return jnp.concatenate(outs, axis=1)


def even_mixer(h, w_in, b_forget, fox_q_norm, fox_k_norm, diff_q_norm, diff_k_norm,
               lambda_q1, lambda_k1, lambda_q2, lambda_k2, diff_subln, w_out, table, lambda_init):
    B, S, _ = h.shape
    proj = h @ w_in
    fq, fk, fv, ff, dq, dk, dv = jnp.split(proj, IN_SPLIT_IDX, axis=-1)
    fq = rms_norm(fq.reshape(B, S, FOX_HEADS, HEAD_DIM), fox_q_norm)
    fk = rms_norm(fk.reshape(B, S, FOX_HEADS, HEAD_DIM), fox_k_norm)
    fv = fv.reshape(B, S, FOX_HEADS, HEAD_DIM)
    log_f = jax.nn.log_sigmoid((ff + b_forget).astype(jnp.float32))
    c = jnp.transpose(jnp.cumsum(log_f, axis=1), (0, 2, 1))
    fox_out = fox_attention(fq, fk, fv, c).reshape(B, S, FOX_W)
    dq = rms_norm(dq.reshape(B, S, DIFF_HEADS, 2, HEAD_DIM), diff_q_norm)
    dk = rms_norm(dk.reshape(B, S, DIFF_HEADS, 2, HEAD_DIM), diff_k_norm)
    dv = dv.reshape(B, S, DIFF_HEADS, 2 * HEAD_DIM)
    f32 = jnp.float32
    lam = (jnp.exp(jnp.sum(lambda_q1.astype(f32) * lambda_k1.astype(f32)))
           - jnp.exp(jnp.sum(lambda_q2.astype(f32) * lambda_k2.astype(f32))) + lambda_init)
    d_out = diff_attention(dq, dk, dv, lam, table[:, :DIFF_HEADS])
    d_out = (rms_norm(d_out, diff_subln) * (1.0 - lambda_init)).reshape(B, S, DIFF_W)
    return jnp.concatenate([fox_out, d_out], axis=-1) @ w_out


def with_prev_block(t):
    prev = jnp.concatenate([jnp.zeros_like(t[:, :1]), t[:, :-1]], axis=1)
    return jnp.concatenate([prev, t], axis=2)


def odd_mixer(h, w_qkv, q_norm, k_norm, sinks, w_out, table):
    B, S, _ = h.shape
    nb = S // WINDOW
    proj = h @ w_qkv
    q, k, v = jnp.split(proj, (SWA_Q_W, SWA_Q_W + SWA_KV_W), axis=-1)
    q = rms_norm(q.reshape(B, S, SWA_HEADS, HEAD_DIM), q_norm)
    k = rms_norm(k.reshape(B, S, SWA_KV_HEADS, HEAD_DIM), k_norm)
    v = v.reshape(B, S, SWA_KV_HEADS, HEAD_DIM)
    qb = q.reshape(B, nb, WINDOW, SWA_KV_HEADS, SWA_GROUP, HEAD_DIM)
    kk = with_prev_block(k.reshape(B, nb, WINDOW, SWA_KV_HEADS, HEAD_DIM))
    vv = with_prev_block(v.reshape(B, nb, WINDOW, SWA_KV_HEADS, HEAD_DIM))
    s = jnp.einsum('bnqhgd,bnkhd->bnhgqk', qb, kk).astype(jnp.float32) * (HEAD_DIM ** -0.5)
    a_idx = jnp.arange(WINDOW)
    b_idx = jnp.arange(2 * WINDOW)
    delta = WINDOW + a_idx[:, None] - b_idx[None, :]
    bias = rel_bias(table, delta).reshape(SWA_KV_HEADS, SWA_GROUP, WINDOW, 2 * WINDOW)
    kpos = jnp.arange(nb)[:, None, None] * WINDOW - WINDOW + b_idx[None, None, :]
    valid = (delta >= 0) & (delta < WINDOW) & (kpos >= 0)
    s = jnp.where(valid[None, :, None, None], s + bias, NEG_INF)
    sink = sinks.astype(jnp.float32).reshape(SWA_KV_HEADS, SWA_GROUP)[None, None, :, :, None, None]
    m = jnp.maximum(jnp.max(s, axis=-1, keepdims=True), sink)
    e = jnp.exp(s - m)
    p = e / (jnp.sum(e, axis=-1, keepdims=True) + jnp.exp(sink - m))
    out = jnp.einsum('bnhgqk,bnkhd->bnqhgd', p.astype(v.dtype), vv).reshape(B, S, SWA_Q_W)
    return out @ w_out


def swiglu(h, w_gate, w_up, w_down):
    return (jax.nn.silu(h @ w_gate) * (h @ w_up)) @ w_down


def setup_inputs(seed: int = 0) -> dict:
    key = jax.random.key(seed)
    ks = iter(jax.random.split(key, 32))

    def nrm(shape, scale):
        return scale * jax.random.normal(next(ks), shape, jnp.float32)

    def gain(shape):
        return 1.0 + nrm(shape, 0.1)

    inv = D_MODEL ** -0.5
    return {
        'x': nrm((BATCH, SEQ, D_MODEL), 1.0),
        'rel_bias_table': nrm((NUM_BUCKETS, REL_HEADS), 0.5),
        'ev_attn_norm': gain((N_EVEN, D_MODEL)),
        'ev_w_in': nrm((N_EVEN, D_MODEL, EVEN_IN_WIDTH), inv),
        'ev_b_forget': 3.0 + nrm((N_EVEN, FOX_HEADS), 0.5),
        'ev_fox_q_norm': gain((N_EVEN, HEAD_DIM)),
        'ev_fox_k_norm': gain((N_EVEN, HEAD_DIM)),
        'ev_diff_q_norm': gain((N_EVEN, HEAD_DIM)),
        'ev_diff_k_norm': gain((N_EVEN, HEAD_DIM)),
        'ev_lambda_q1': nrm((N_EVEN, HEAD_DIM), 0.1),
        'ev_lambda_k1': nrm((N_EVEN, HEAD_DIM), 0.1),
        'ev_lambda_q2': nrm((N_EVEN, HEAD_DIM), 0.1),
        'ev_lambda_k2': nrm((N_EVEN, HEAD_DIM), 0.1),
        'ev_diff_subln': gain((N_EVEN, 2 * HEAD_DIM)),
        'ev_w_out': nrm((N_EVEN, MIX_WIDTH, D_MODEL), MIX_WIDTH ** -0.5),
        'od_attn_norm': gain((N_ODD, D_MODEL)),
        'od_w_qkv': nrm((N_ODD, D_MODEL, SWA_QKV_WIDTH), inv),
        'od_q_norm': gain((N_ODD, HEAD_DIM)),
        'od_k_norm': gain((N_ODD, HEAD_DIM)),
        'od_sinks': nrm((N_ODD, SWA_HEADS), 0.5),
        'od_w_out': nrm((N_ODD, SWA_Q_W, D_MODEL), SWA_Q_W ** -0.5),
        'ffn_norm': gain((DEPTH, D_MODEL)),
        'w_gate': nrm((DEPTH, D_MODEL, FFN_HIDDEN), inv),
        'w_up': nrm((DEPTH, D_MODEL, FFN_HIDDEN), inv),
        'w_down': nrm((DEPTH, FFN_HIDDEN, D_MODEL), FFN_HIDDEN ** -0.5),
    }


def reference(x, rel_bias_table, ev_attn_norm, ev_w_in, ev_b_forget, ev_fox_q_norm, ev_fox_k_norm,
              ev_diff_q_norm, ev_diff_k_norm, ev_lambda_q1, ev_lambda_k1, ev_lambda_q2, ev_lambda_k2,
              ev_diff_subln, ev_w_out, od_attn_norm, od_w_qkv, od_q_norm, od_k_norm, od_sinks, od_w_out,
              ffn_norm, w_gate, w_up, w_down):
    for layer in range(DEPTH):
        j = layer // 2
        if layer % 2 == 0:
            lambda_init = 0.8 - 0.6 * math.exp(-0.3 * layer)
            h = rms_norm(x, ev_attn_norm[j])
            x = x + even_mixer(h, ev_w_in[j], ev_b_forget[j], ev_fox_q_norm[j], ev_fox_k_norm[j],
                               ev_diff_q_norm[j], ev_diff_k_norm[j], ev_lambda_q1[j], ev_lambda_k1[j],
                               ev_lambda_q2[j], ev_lambda_k2[j], ev_diff_subln[j], ev_w_out[j],
                               rel_bias_table, lambda_init)
        else:
            h = rms_norm(x, od_attn_norm[j])
            x = x + odd_mixer(h, od_w_qkv[j], od_q_norm[j], od_k_norm[j], od_sinks[j], od_w_out[j],
                              rel_bias_table)
        h = rms_norm(x, ffn_norm[layer])
        x = x + swiglu(h, w_gate[layer], w_up[layer], w_down[layer])
    return x
```

```cpp
#include <hip/hip_runtime.h>
#include <math.h>

namespace v1 {
constexpr int DM = 1024, NB = 16, SQ = 2048, EVW = 3080, FFN = 2816, QKVW = 1536;
constexpr int C_FQ = 0, C_FK = 512, C_FV = 1024, C_FF = 1536, C_DQ = 1544, C_DK = 2056, C_DV = 2568;

__device__ const unsigned char kBucket[128] = {
    0, 1, 2, 3, 4, 5, 6, 7, 8, 9, 10, 11, 12, 13, 14, 15, 16, 16, 16, 17, 17, 18, 18, 18, 19, 19, 19, 20, 20, 20, 20, 21,
    21, 21, 21, 22, 22, 22, 22, 22, 23, 23, 23, 23, 23, 23, 24, 24, 24, 24, 24, 24, 25, 25, 25, 25, 25, 25, 25, 26, 26, 26, 26, 26,
    26, 26, 26, 27, 27, 27, 27, 27, 27, 27, 27, 27, 27, 28, 28, 28, 28, 28, 28, 28, 28, 28, 28, 29, 29, 29, 29, 29, 29, 29, 29, 29,
    29, 29, 29, 30, 30, 30, 30, 30, 30, 30, 30, 30, 30, 30, 30, 30, 30, 31, 31, 31, 31, 31, 31, 31, 31, 31, 31, 31, 31, 31, 31, 31};

__device__ __forceinline__ float wave_sum(float v) {
#pragma unroll
    for (int o = 1; o < 64; o <<= 1) v += __shfl_xor(v, o);
    return v;
}

__global__ __launch_bounds__(256) void rmsnorm_k(const float* __restrict__ x, const float* __restrict__ g, float* __restrict__ y, int rows) {
    const int wave = threadIdx.x >> 6, lane = threadIdx.x & 63;
    const int row = blockIdx.x * 4 + wave;
    if (row >= rows) return;
    const float4* xr = (const float4*)(x + (size_t)row * DM);
    const float4* gr = (const float4*)g;
    float4 v[4];
    float s = 0.f;
#pragma unroll
    for (int j = 0; j < 4; ++j) { v[j] = xr[lane + 64 * j]; s += v[j].x * v[j].x + v[j].y * v[j].y + v[j].z * v[j].z + v[j].w * v[j].w; }
    s = wave_sum(s);
    const float r = rsqrtf(s * (1.0f / DM) + 1e-6f);
    float4* yr = (float4*)(y + (size_t)row * DM);
#pragma unroll
    for (int j = 0; j < 4; ++j) { const float4 gg = gr[lane + 64 * j]; float4 o; o.x = v[j].x * r * gg.x; o.y = v[j].y * r * gg.y; o.z = v[j].z * r * gg.z; o.w = v[j].w * r * gg.w; yr[lane + 64 * j] = o; }
}

__global__ __launch_bounds__(256) void gemm_f32(const float* __restrict__ A, int lda, const float* __restrict__ Bm, int ldb, float* __restrict__ C, int ldc,
                                                const float* __restrict__ R, int ldr, int M, int N, int K) {
    __shared__ float As[16][68];
    __shared__ float Bs[16][68];
    const int tx = threadIdx.x & 15, ty = threadIdx.x >> 4;
    const int m0 = blockIdx.y * 64, n0 = blockIdx.x * 64;
    float acc[4][4];
#pragma unroll
    for (int i = 0; i < 4; ++i)
#pragma unroll
        for (int j = 0; j < 4; ++j) acc[i][j] = 0.f;
    const int ar = threadIdx.x >> 2, ak = (threadIdx.x & 3) * 4;
    const int br = threadIdx.x >> 4, bc = (threadIdx.x & 15) * 4;
    const int nc = n0 + bc;
    for (int k0 = 0; k0 < K; k0 += 16) {
        const float4 av = *(const float4*)(A + (size_t)(m0 + ar) * lda + k0 + ak);
        float4 bv = make_float4(0.f, 0.f, 0.f, 0.f);
        if (nc < N) bv = *(const float4*)(Bm + (size_t)(k0 + br) * ldb + nc);
        As[ak + 0][ar] = av.x; As[ak + 1][ar] = av.y; As[ak + 2][ar] = av.z; As[ak + 3][ar] = av.w;
        *(float4*)&Bs[br][bc] = bv;
        __syncthreads();
#pragma unroll
        for (int kk = 0; kk < 16; ++kk) {
            const float4 a = *(const float4*)&As[kk][ty * 4];
            const float4 b = *(const float4*)&Bs[kk][tx * 4];
            const float aa[4] = {a.x, a.y, a.z, a.w}, bb[4] = {b.x, b.y, b.z, b.w};
#pragma unroll
            for (int i = 0; i < 4; ++i)
#pragma unroll
                for (int j = 0; j < 4; ++j) acc[i][j] = fmaf(aa[i], bb[j], acc[i][j]);
        }
        __syncthreads();
    }
    const int cn = n0 + tx * 4;
    if (cn < N) {
#pragma unroll
        for (int i = 0; i < 4; ++i) {
            const int row = m0 + ty * 4 + i;
            float4 o = make_float4(acc[i][0], acc[i][1], acc[i][2], acc[i][3]);
            if (R) { const float4 rv = *(const float4*)(R + (size_t)row * ldr + cn); o.x += rv.x; o.y += rv.y; o.z += rv.z; o.w += rv.w; }
            *(float4*)(C + (size_t)row * ldc + cn) = o;
        }
    }
}

struct NormSpec { int col0[4]; int ngroups[4]; const float* gain[4]; int nr; int ld; };
__global__ __launch_bounds__(256) void groupnorm_k(float* __restrict__ p, NormSpec sp, int rows, int groups_per_row) {
    const int t = blockIdx.x * blockDim.x + threadIdx.x;
    if (t >= rows * groups_per_row) return;
    const int row = t / groups_per_row;
    int g = t % groups_per_row;
    int c0 = sp.col0[0]; const float* gn = sp.gain[0];
    if (g >= sp.ngroups[0]) { g -= sp.ngroups[0]; c0 = sp.col0[1]; gn = sp.gain[1];
        if (g >= sp.ngroups[1]) { g -= sp.ngroups[1]; c0 = sp.col0[2]; gn = sp.gain[2];
            if (g >= sp.ngroups[2]) { g -= sp.ngroups[2]; c0 = sp.col0[3]; gn = sp.gain[3]; } } }
    float* q = p + (size_t)row * sp.ld + c0 + g * 64;
    float v[64];
    float s = 0.f;
#pragma unroll
    for (int i = 0; i < 16; ++i) { const float4 a = ((const float4*)q)[i]; v[4 * i] = a.x; v[4 * i + 1] = a.y; v[4 * i + 2] = a.z; v[4 * i + 3] = a.w; s += a.x * a.x + a.y * a.y + a.z * a.z + a.w * a.w; }
    const float rr = rsqrtf(s * (1.0f / 64.0f) + 1e-6f);
#pragma unroll
    for (int i = 0; i < 16; ++i) { float4 o; o.x = v[4 * i] * rr * gn[4 * i]; o.y = v[4 * i + 1] * rr * gn[4 * i + 1]; o.z = v[4 * i + 2] * rr * gn[4 * i + 2]; o.w = v[4 * i + 3] * rr * gn[4 * i + 3]; ((float4*)q)[i] = o; }
}

__global__ __launch_bounds__(256) void cumsum_k(const float* __restrict__ proj, const float* __restrict__ bf, float* __restrict__ c) {
    __shared__ float sc[256];
    const int h = blockIdx.x, t = threadIdx.x;
    const float b = bf[h];
    float loc[8];
    float run = 0.f;
#pragma unroll
    for (int i = 0; i < 8; ++i) {
        const float z = proj[(size_t)(t * 8 + i) * EVW + C_FF + h] + b;
        const float ls = fminf(z, 0.f) - log1pf(expf(-fabsf(z)));
        run += ls; loc[i] = run;
    }
    sc[t] = run;
    __syncthreads();
    for (int o = 1; o < 256; o <<= 1) {
        float add = (t >= o) ? sc[t - o] : 0.f;
        __syncthreads();
        sc[t] += add;
        __syncthreads();
    }
    const float off = sc[t] - run;
#pragma unroll
    for (int i = 0; i < 8; ++i) c[h * SQ + t * 8 + i] = loc[i] + off;
}

__global__ __launch_bounds__(128) void fox_attn_k(const float* __restrict__ proj, const float* __restrict__ c, float* __restrict__ mix) {
    const int h = blockIdx.y, q0 = blockIdx.x * 128, qp = q0 + threadIdx.x;
    float q[64], acc[64];
    const float* qr = proj + (size_t)qp * EVW + C_FQ + h * 64;
#pragma unroll
    for (int d = 0; d < 64; ++d) { q[d] = qr[d] * 0.125f; acc[d] = 0.f; }
    const float cq = c[h * SQ + qp];
    float m = -1e30f, l = 0.f;
    const int kend = q0 + 128;
    for (int k = 0; k < kend; ++k) {
        const float* kr = proj + (size_t)k * EVW + C_FK + h * 64;
        const float* vr = proj + (size_t)k * EVW + C_FV + h * 64;
        float s = 0.f;
#pragma unroll
        for (int d = 0; d < 64; ++d) s = fmaf(q[d], kr[d], s);
        s += cq - c[h * SQ + k];
        if (k <= qp) {
            const float mn = fmaxf(m, s);
            const float corr = __expf(m - mn), p = __expf(s - mn);
            l = l * corr + p;
#pragma unroll
            for (int d = 0; d < 64; ++d) acc[d] = fmaf(acc[d], corr, p * vr[d]);
            m = mn;
        }
    }
    const float il = 1.0f / l;
    float* o = mix + (size_t)qp * DM + h * 64;
#pragma unroll
    for (int d = 0; d < 64; ++d) o[d] = acc[d] * il;
}

__global__ __launch_bounds__(256) void diff_attn_k(const float* __restrict__ proj, const float* __restrict__ table, float* __restrict__ dtmp) {
    __shared__ float lut[129];
    const int h = blockIdx.y, q0 = blockIdx.x * 64;
    if (threadIdx.x < 128) lut[threadIdx.x] = table[kBucket[threadIdx.x] * 16 + h];
    if (threadIdx.x == 128) lut[128] = table[31 * 16 + h];
    __syncthreads();
    const int w = threadIdx.x >> 6, lane = threadIdx.x & 63, m_ = w >> 1, vh = w & 1, qp = q0 + lane;
    float q[64], acc[64];
    const float* qr = proj + (size_t)qp * EVW + C_DQ + h * 128 + m_ * 64;
#pragma unroll
    for (int d = 0; d < 64; ++d) { q[d] = qr[d] * 0.125f; acc[d] = 0.f; }
    float m = -1e30f, l = 0.f;
    const int kend = q0 + 64;
    for (int k = 0; k < kend; ++k) {
        const float* kr = proj + (size_t)k * EVW + C_DK + h * 128 + m_ * 64;
        const float* vr = proj + (size_t)k * EVW + C_DV + h * 128 + vh * 64;
        float s = 0.f;
#pragma unroll
        for (int d = 0; d < 64; ++d) s = fmaf(q[d], kr[d], s);
        if (k <= qp) {
            const int dl = qp - k;
            s += lut[dl < 128 ? dl : 128];
            const float mn = fmaxf(m, s);
            const float corr = __expf(m - mn), p = __expf(s - mn);
            l = l * corr + p;
#pragma unroll
            for (int d = 0; d < 64; ++d) acc[d] = fmaf(acc[d], corr, p * vr[d]);
            m = mn;
        }
    }
    const float il = 1.0f / l;
    float* o = dtmp + (size_t)m_ * SQ * 512 + (size_t)qp * 512 + h * 128 + vh * 64;
#pragma unroll
    for (int d = 0; d < 64; ++d) o[d] = acc[d] * il;
}

__global__ __launch_bounds__(256) void diff_combine_k(const float* __restrict__ dtmp, const float* __restrict__ lq1, const float* __restrict__ lk1, const float* __restrict__ lq2,
                                                      const float* __restrict__ lk2, const float* __restrict__ subln, float* __restrict__ mix, float lambda_init) {
    const int t = blockIdx.x * blockDim.x + threadIdx.x;
    if (t >= SQ * 4) return;
    const int row = t >> 2, h = t & 3;
    float s1 = 0.f, s2 = 0.f;
    for (int i = 0; i < 64; ++i) { s1 += lq1[i] * lk1[i]; s2 += lq2[i] * lk2[i]; }
    const float lam = expf(s1) - expf(s2) + lambda_init;
    const float* o0 = dtmp + (size_t)row * 512 + h * 128;
    const float* o1 = dtmp + (size_t)SQ * 512 + (size_t)row * 512 + h * 128;
    float ss = 0.f;
    for (int e = 0; e < 128; ++e) { const float d = o0[e] - lam * o1[e]; ss += d * d; }
    const float r = rsqrtf(ss * (1.0f / 128.0f) + 1e-6f);
    float* o = mix + (size_t)row * DM + 512 + h * 128;
    for (int e = 0; e < 128; ++e) { const float d = o0[e] - lam * o1[e]; o[e] = d * r * subln[e] * (1.0f - lambda_init); }
}

__global__ __launch_bounds__(128) void swa_attn_k(const float* __restrict__ qkv, const float* __restrict__ table, const float* __restrict__ sinks, float* __restrict__ mix) {
    __shared__ float lut[128];
    const int h = blockIdx.y, kvh = h >> 2, q0 = blockIdx.x * 128, qp = q0 + threadIdx.x;
    lut[threadIdx.x] = table[kBucket[threadIdx.x] * 16 + h];
    __syncthreads();
    float q[64], acc[64];
    const float* qr = qkv + (size_t)qp * QKVW + h * 64;
#pragma unroll
    for (int d = 0; d < 64; ++d) { q[d] = qr[d] * 0.125f; acc[d] = 0.f; }
    float m = sinks[h], l = 1.0f;
    int kbeg = q0 - 127; if (kbeg < 0) kbeg = 0;
    const int kend = q0 + 128;
    for (int k = kbeg; k < kend; ++k) {
        const float* kr = qkv + (size_t)k * QKVW + 1024 + kvh * 64;
        const float* vr = qkv + (size_t)k * QKVW + 1280 + kvh * 64;
        float s = 0.f;
#pragma unroll
        for (int d = 0; d < 64; ++d) s = fmaf(q[d], kr[d], s);
        const int dl = qp - k;
        if (dl >= 0 && dl < 128) {
            s += lut[dl];
            const float mn = fmaxf(m, s);
            const float corr = __expf(m - mn), p = __expf(s - mn);
            l = l * corr + p;
#pragma unroll
            for (int d = 0; d < 64; ++d) acc[d] = fmaf(acc[d], corr, p * vr[d]);
            m = mn;
        }
    }
    const float il = 1.0f / l;
    float* o = mix + (size_t)qp * DM + h * 64;
#pragma unroll
    for (int d = 0; d < 64; ++d) o[d] = acc[d] * il;
}

__global__ __launch_bounds__(256) void silu_mul_k(float* __restrict__ g, const float* __restrict__ u, int n4) {
    const int t = blockIdx.x * blockDim.x + threadIdx.x;
    if (t >= n4) return;
    float4 a = ((float4*)g)[t];
    const float4 b = ((const float4*)u)[t];
    a.x = a.x / (1.0f + expf(-a.x)) * b.x; a.y = a.y / (1.0f + expf(-a.y)) * b.y; a.z = a.z / (1.0f + expf(-a.z)) * b.z; a.w = a.w / (1.0f + expf(-a.w)) * b.w;
    ((float4*)g)[t] = a;
}

static void gemm(hipStream_t st, const float* A, int lda, const float* Bm, int ldb, float* C, int ldc, const float* R, int ldr, int M, int N, int K) {
    dim3 grid((N + 63) / 64, M / 64);
    hipLaunchKernelGGL(gemm_f32, grid, dim3(256), 0, st, A, lda, Bm, ldb, C, ldc, R, ldr, M, N, K);
}
}

extern "C" void kernel_launch(void* const* d_in, const int* in_sizes, int n_in, void* d_out, int out_size, void* d_ws, size_t ws_size, hipStream_t stream) {
    using namespace v1;
    const float* x = (const float*)d_in[0];
    const float* table = (const float*)d_in[1];
    const float* ev_attn_norm = (const float*)d_in[2];
    const float* ev_w_in = (const float*)d_in[3];
    const float* ev_b_forget = (const float*)d_in[4];
    const float* ev_fox_q_norm = (const float*)d_in[5];
    const float* ev_fox_k_norm = (const float*)d_in[6];
    const float* ev_diff_q_norm = (const float*)d_in[7];
    const float* ev_diff_k_norm = (const float*)d_in[8];
    const float* lq1 = (const float*)d_in[9];
    const float* lk1 = (const float*)d_in[10];
    const float* lq2 = (const float*)d_in[11];
    const float* lk2 = (const float*)d_in[12];
    const float* subln = (const float*)d_in[13];
    const float* ev_w_out = (const float*)d_in[14];
    const float* od_attn_norm = (const float*)d_in[15];
    const float* od_w_qkv = (const float*)d_in[16];
    const float* od_q_norm = (const float*)d_in[17];
    const float* od_k_norm = (const float*)d_in[18];
    const float* od_sinks = (const float*)d_in[19];
    const float* od_w_out = (const float*)d_in[20];
    const float* ffn_norm = (const float*)d_in[21];
    const float* w_gate = (const float*)d_in[22];
    const float* w_up = (const float*)d_in[23];
    const float* w_down = (const float*)d_in[24];
    float* out = (float*)d_out;

    float* ws = (float*)d_ws;
    size_t off = 0;
    auto take = [&](size_t n) { float* p = ws + off; off += (n + 63) & ~(size_t)63; return p; };
    float* hbuf = take((size_t)SQ * DM);
    float* proj = take((size_t)SQ * EVW);
    float* cbuf = take((size_t)8 * SQ);
    float* mix = take((size_t)SQ * DM);
    float* dtmp = take((size_t)2 * SQ * 512);
    float* x1 = take((size_t)SQ * DM);
    float* x2 = take((size_t)SQ * DM);
    float* x3 = take((size_t)SQ * DM);
    float* gb = take((size_t)SQ * FFN);
    float* ub = take((size_t)SQ * FFN);

    const float lambda_init0 = 0.8f - 0.6f * 1.0f;

    for (int b = 0; b < NB; ++b) {
        const float* xb = x + (size_t)b * SQ * DM;
        float* ob = out + (size_t)b * SQ * DM;
        hipLaunchKernelGGL(rmsnorm_k, dim3(SQ / 4), dim3(256), 0, stream, xb, ev_attn_norm, hbuf, SQ);
        gemm(stream, hbuf, DM, ev_w_in, EVW, proj, EVW, nullptr, 0, SQ, EVW, DM);
        {
            NormSpec sp{};
            sp.col0[0] = C_FQ; sp.ngroups[0] = 8; sp.gain[0] = ev_fox_q_norm;
            sp.col0[1] = C_FK; sp.ngroups[1] = 8; sp.gain[1] = ev_fox_k_norm;
            sp.col0[2] = C_DQ; sp.ngroups[2] = 8; sp.gain[2] = ev_diff_q_norm;
            sp.col0[3] = C_DK; sp.ngroups[3] = 8; sp.gain[3] = ev_diff_k_norm;
            sp.nr = 4; sp.ld = EVW;
            hipLaunchKernelGGL(groupnorm_k, dim3(SQ * 32 / 256), dim3(256), 0, stream, proj, sp, SQ, 32);
        }
        hipLaunchKernelGGL(cumsum_k, dim3(8), dim3(256), 0, stream, proj, ev_b_forget, cbuf);
        hipLaunchKernelGGL(fox_attn_k, dim3(SQ / 128, 8), dim3(128), 0, stream, proj, cbuf, mix);
        hipLaunchKernelGGL(diff_attn_k, dim3(SQ / 64, 4), dim3(256), 0, stream, proj, table, dtmp);
        hipLaunchKernelGGL(diff_combine_k, dim3(SQ * 4 / 256), dim3(256), 0, stream, dtmp, lq1, lk1, lq2, lk2, subln, mix, lambda_init0);
        gemm(stream, mix, DM, ev_w_out, DM, x1, DM, xb, DM, SQ, DM, DM);
        hipLaunchKernelGGL(rmsnorm_k, dim3(SQ / 4), dim3(256), 0, stream, x1, ffn_norm, hbuf, SQ);
        gemm(stream, hbuf, DM, w_gate, FFN, gb, FFN, nullptr, 0, SQ, FFN, DM);
        gemm(stream, hbuf, DM, w_up, FFN, ub, FFN, nullptr, 0, SQ, FFN, DM);
        hipLaunchKernelGGL(silu_mul_k, dim3(SQ * FFN / 4 / 256), dim3(256), 0, stream, gb, ub, SQ * FFN / 4);
        gemm(stream, gb, FFN, w_down, DM, x2, DM, x1, DM, SQ, DM, FFN);
        hipLaunchKernelGGL(rmsnorm_k, dim3(SQ / 4), dim3(256), 0, stream, x2, od_attn_norm, hbuf, SQ);
        gemm(stream, hbuf, DM, od_w_qkv, QKVW, proj, QKVW, nullptr, 0, SQ, QKVW, DM);
        {
            NormSpec sp{};
            sp.col0[0] = 0; sp.ngroups[0] = 16; sp.gain[0] = od_q_norm;
            sp.col0[1] = 1024; sp.ngroups[1] = 4; sp.gain[1] = od_k_norm;
            sp.col0[2] = 0; sp.ngroups[2] = 0; sp.gain[2] = od_k_norm;
            sp.col0[3] = 0; sp.ngroups[3] = 0; sp.gain[3] = od_k_norm;
            sp.nr = 2; sp.ld = QKVW;
            hipLaunchKernelGGL(groupnorm_k, dim3(SQ * 20 / 256), dim3(256), 0, stream, proj, sp, SQ, 20);
        }
        hipLaunchKernelGGL(swa_attn_k, dim3(SQ / 128, 16), dim3(128), 0, stream, proj, table, od_sinks, mix);
        gemm(stream, mix, DM, od_w_out, DM, x3, DM, x2, DM, SQ, DM, DM);
        hipLaunchKernelGGL(rmsnorm_k, dim3(SQ / 4), dim3(256), 0, stream, x3, ffn_norm + DM, hbuf, SQ);
        gemm(stream, hbuf, DM, w_gate + (size_t)DM * FFN, FFN, gb, FFN, nullptr, 0, SQ, FFN, DM);
        gemm(stream, hbuf, DM, w_up + (size_t)DM * FFN, FFN, ub, FFN, nullptr, 0, SQ, FFN, DM);
        hipLaunchKernelGGL(silu_mul_k, dim3(SQ * FFN / 4 / 256), dim3(256), 0, stream, gb, ub, SQ * FFN / 4);
        gemm(stream, gb, FFN, w_down + (size_t)FFN * DM, DM, ob, DM, x3, DM, SQ, DM, FFN);
    }
}
```

```cpp
#include <hip/hip_runtime.h>
#include <cstdio>
#include <cstdint>
#include <cmath>
#define MK_MODE 2
#define REP_MASK 0
namespace pg8 {
#define PG8_LAS __attribute__((address_space(3)))
typedef unsigned short bf16_t;
typedef short bf16x8 __attribute__((ext_vector_type(8)));
typedef float f32x4 __attribute__((ext_vector_type(4)));
typedef unsigned u32x4 __attribute__((ext_vector_type(4)));
constexpr int BM = 256, BK = 64, HALF = 128, HTB = HALF * BK * 2  , STAGE_BYTES = 8 * HTB, NXCD = 8, WGM = 8;

__host__ __device__ __forceinline__ int lds_byte(int r, int c) { const int st = (r >> 4) * 2 + (c >> 5), rr = r & 15, cc = c & 31, ob = rr * 64 + cc * 2; return st * 1024 + (ob ^ (((ob >> 9) & 1) << 5)); }
__host__ __device__ __forceinline__ void stage_rc(int b, int& R, int& C) { const int st = b / 1024, sb = b % 1024, swz = sb ^ (((sb >> 9) & 1) << 5); R = (st >> 1) * 16 + swz / 64; C = (st & 1) * 32 + (swz % 64) / 2; }
__host__ __device__ __forceinline__ int perm32(int rho) { const int n = rho >> 4, i = rho & 15; return 8 * (i >> 2) + 4 * n + (i & 3); }

struct Unit { int pm, pn; };
struct Gemm { const bf16_t* A; const bf16_t* Bt; int M, N, K; };

struct StaticOrder {
    int nM, nN, nwg, G, c, wgm;
    __host__ __device__ void init(int M, int N, int G_, int c_, int wgm_ = WGM) { nM = M / BM; nN = N / BM; nwg = nM * nN; G = G_; c = c_; wgm = wgm_; }
    __host__ __device__ bool next(int i, Unit& u) const {
        const long L = (long)i * G + c; if (L >= nwg) return false;
        int wgid = (int)L; { const int q = nwg / NXCD, r = nwg % NXCD, xcd = wgid % NXCD, off = wgid / NXCD; wgid = (xcd < r ? xcd * (q + 1) : r * (q + 1) + (xcd - r) * q) + off; }
        const int nig = wgm * nN, gid = wgid / nig, fm = gid * wgm, gsz = (nM - fm) < wgm ? (nM - fm) : wgm;
        u.pm = fm + ((wgid % nig) % gsz); u.pn = (wgid % nig) / gsz; return true;
    }
    __device__ __forceinline__ void a_ready(const Unit&) const {}
    __device__ __forceinline__ void done(const Unit&) const {}
};

__device__ __forceinline__ unsigned cvt_pk_bf16(float lo, float hi) { unsigned r; asm volatile("v_cvt_pk_bf16_f32 %0, %1, %2" : "=v"(r) : "v"(lo), "v"(hi)); return r; }
typedef float f32x2 __attribute__((ext_vector_type(2)));

constexpr float RMS_EPS = 1e-6f;
constexpr float LOG2E = 1.4426950408889634f;
constexpr float QSCALE = 0.125f * LOG2E;
__device__ __forceinline__ float row_ss(const float* ssq, int row) { const f32x4 p = *(const f32x4*)(ssq + (size_t)row * 4); return (p[0] + p[1]) + (p[2] + p[3]); }

constexpr int PF_SSQ_OFF = 131072, PF_GT_OFF = 135168;
__device__ __forceinline__ void pf_issue(const float* ssq, const float* gt, const Unit& u, PG8_LAS unsigned char* lds, int wid, int lane) {
    if (gt != nullptr && wid >= 4) __builtin_amdgcn_global_load_lds((const unsigned*)(gt + (lane & 15) * 4), (PG8_LAS unsigned*)(lds + PF_GT_OFF), 16, 0, 0);
    else __builtin_amdgcn_global_load_lds((const unsigned*)(ssq + ((size_t)(u.pm * BM + (wid & 3) * 64 + lane)) * 4), (PG8_LAS unsigned*)(lds + PF_SSQ_OFF + (wid & 3) * 1024), 16, 0, 0);
}
__device__ __forceinline__ float row_ss_lds(PG8_LAS const unsigned char* lds, int lrow) { const f32x4 p = *(PG8_LAS const f32x4*)(lds + PF_SSQ_OFF + lrow * 16); return (p[0] + p[1]) + (p[2] + p[3]); }

template <int LAYER> struct EpiQKV {
    static constexpr bool PERM = true, AFTER_DRAIN = false, PF = true;
    bf16_t* O; int ldc; const float* ssq; const float* gtab; PG8_LAS unsigned char* lds;
    __device__ __forceinline__ void prefetch(const Unit& u, int wid, int lane) const { pf_issue(ssq, gtab + u.pn * 64, u, lds, wid, lane); }
    __device__ __forceinline__ void operator()(const f32x4 (&acc)[2][2][4][2], const Unit& u, int wr, int wc, int fr, int fq) const {
        int kind;
        if (LAYER == 0) kind = (u.pn >> 1) % 3; else kind = u.pn < 4 ? 0 : u.pn - 3;
        const int row0 = u.pm * BM + wr * 64 + fr;
        const int col0 = u.pn * BM + wc * 64 + 8 * fq;
        f32x4 gv[2][2];
#pragma unroll
        for (int bj = 0; bj < 2; ++bj)
#pragma unroll
            for (int n = 0; n < 2; ++n) {
                gv[bj][n] = *(PG8_LAS const f32x4*)(lds + PF_GT_OFF + (32 * bj + 8 * fq + 4 * n) * 4);
            }
        float rsv[8];
#pragma unroll
        for (int q = 0; q < 8; ++q) rsv[q] = row_ss_lds(lds, wr * 64 + fr + (q >> 2) * HALF + (q & 3) * 16);
#pragma unroll
        for (int q = 0; q < 8; ++q) rsv[q] = __builtin_amdgcn_rsqf(rsv[q] * (1.0f / 1024.0f) + RMS_EPS);
#pragma unroll
        for (int ai = 0; ai < 2; ++ai)
#pragma unroll
            for (int m = 0; m < 4; ++m) {
                const int row = row0 + ai * HALF + m * 16;
                const float rs = rsv[ai * 4 + m];
                f32x2 ssv = {0.f, 0.f};
                if (kind < 2) {
#pragma unroll
                    for (int bj = 0; bj < 2; ++bj)
#pragma unroll
                        for (int n = 0; n < 2; ++n) { const f32x4 t = acc[ai][bj][m][n]; const f32x2 t0 = {t[0], t[1]}, t1 = {t[2], t[3]}; ssv = t0 * t0 + ssv; ssv = t1 * t1 + ssv; }
                }
                float sc = rs;
                if (kind < 2) {
                    float ss = (ssv[0] + ssv[1]) * (rs * rs);
                    ss += __shfl_xor(ss, 16); ss += __shfl_xor(ss, 32);
                    sc = rs * __builtin_amdgcn_rsqf(ss * (1.0f / 64.0f) + RMS_EPS);
                }
                const f32x2 scv = {sc, sc};
                f32x4 v[2][2];
#pragma unroll
                for (int bj = 0; bj < 2; ++bj)
#pragma unroll
                    for (int n = 0; n < 2; ++n) {
                        const f32x4 t = acc[ai][bj][m][n], g = gv[bj][n];
                        f32x2 g0 = {g[0], g[1]}, g1 = {g[2], g[3]};
                        if (kind < 2) { g0 = g0 * scv; g1 = g1 * scv; } else { g0 = scv; g1 = scv; }
                        const f32x2 o0 = (f32x2){t[0], t[1]} * g0, o1 = (f32x2){t[2], t[3]} * g1;
                        v[bj][n] = (f32x4){o0[0], o0[1], o1[0], o1[1]};
                    }
                bf16_t* rowp = O + (size_t)row * ldc + col0;
#pragma unroll
                for (int bj = 0; bj < 2; ++bj) {
                    u32x4 w; w.x = cvt_pk_bf16(v[bj][0][0], v[bj][0][1]); w.y = cvt_pk_bf16(v[bj][0][2], v[bj][0][3]); w.z = cvt_pk_bf16(v[bj][1][0], v[bj][1][1]); w.w = cvt_pk_bf16(v[bj][1][2], v[bj][1][3]);
                    *(u32x4*)(rowp + 32 * bj) = w;
                }
            }
    }
};

template <bool FINAL> struct EpiRes {
    static constexpr bool PERM = true, AFTER_DRAIN = false, PF = false;
    const bf16_t* res; bf16_t* outb; float* outf; float* ssq; PG8_LAS float* xs;
    __device__ __forceinline__ void operator()(const f32x4 (&acc)[2][2][4][2], const Unit& u, int wr, int wc, int fr, int fq) const {
        const int row0 = u.pm * BM + wr * 64 + fr, col0 = u.pn * BM + wc * 32 + 8 * fq;
#pragma unroll
        for (int ai = 0; ai < 2; ++ai) {
            u32x4 pre[4][2];
#pragma unroll
            for (int m = 0; m < 4; ++m)
#pragma unroll
                for (int bj = 0; bj < 2; ++bj) pre[m][bj] = *(const u32x4*)(res + ((unsigned)(row0 + ai * HALF + m * 16) * 1024u + (unsigned)(col0 + bj * HALF)));
#pragma unroll
            for (int m = 0; m < 4; ++m) {
                const int row = row0 + ai * HALF + m * 16; const unsigned off = (unsigned)row * 1024u + (unsigned)col0;
                f32x2 ssv = {0.f, 0.f};
#pragma unroll
                for (int bj = 0; bj < 2; ++bj) {
                    const unsigned c = off + (unsigned)(bj * HALF);
                    const u32x4 rv = pre[m][bj];
                    f32x4 o0, o1;
                    o0[0] = __builtin_bit_cast(float, rv.x << 16); o0[1] = __builtin_bit_cast(float, rv.x & 0xffff0000u); o0[2] = __builtin_bit_cast(float, rv.y << 16); o0[3] = __builtin_bit_cast(float, rv.y & 0xffff0000u);
                    o1[0] = __builtin_bit_cast(float, rv.z << 16); o1[1] = __builtin_bit_cast(float, rv.z & 0xffff0000u); o1[2] = __builtin_bit_cast(float, rv.w << 16); o1[3] = __builtin_bit_cast(float, rv.w & 0xffff0000u);
                    o0 = o0 + acc[ai][bj][m][0]; o1 = o1 + acc[ai][bj][m][1];
#if defined(PROBE_STAMP) || defined(PROBE_STEPS) || defined(PROBE_CYC) || defined(PROBE_IMBAL)
                    if (FINAL && c == 0) o0[0] += ssq[0];
#endif
                    if (FINAL) { *(f32x4*)(outf + c) = o0; *(f32x4*)(outf + c + 4) = o1; }
                    else {
                        { const f32x2 a0 = {o0[0], o0[1]}, a1 = {o0[2], o0[3]}, a2 = {o1[0], o1[1]}, a3 = {o1[2], o1[3]}; ssv = a0 * a0 + ssv; ssv = a1 * a1 + ssv; ssv = a2 * a2 + ssv; ssv = a3 * a3 + ssv; }
                        u32x4 w; w.x = cvt_pk_bf16(o0[0], o0[1]); w.y = cvt_pk_bf16(o0[2], o0[3]); w.z = cvt_pk_bf16(o1[0], o1[1]); w.w = cvt_pk_bf16(o1[2], o1[3]);
                        *(u32x4*)(outb + c) = w;
                    }
                }
                if (!FINAL) { float ss = ssv[0] + ssv[1]; ss += __shfl_xor(ss, 16); ss += __shfl_xor(ss, 32); if (fq == 0) xs[(ai * HALF + wr * 64 + m * 16 + fr) * 4 + wc] = ss; }
            }
        }
        if (!FINAL) {
            asm volatile("s_waitcnt lgkmcnt(0)\n\ts_barrier" ::: "memory");
            const int tid = (wr * 4 + wc) * 64 + fq * 16 + fr;
            if (tid < 256) { const f32x4 v = *(const PG8_LAS f32x4*)(xs + tid * 4); ssq[(size_t)(u.pm * BM + tid) * 4 + u.pn] = (v[0] + v[1]) + (v[2] + v[3]); }
        }
    }
};

struct EpiSwiGLU {
    static constexpr bool PERM = true, AFTER_DRAIN = false, PF = true;
    bf16_t* H; int ldh; const float* ssq; PG8_LAS unsigned char* lds;
    __device__ __forceinline__ void prefetch(const Unit& u, int wid, int lane) const { pf_issue(ssq, nullptr, u, lds, wid, lane); }
    __device__ __forceinline__ void operator()(const f32x4 (&acc)[2][2][4][2], const Unit& u, int wr, int wc, int fr, int fq) const {
        const int row0 = u.pm * BM + wr * 64 + fr, hcol = u.pn * HALF + wc * 32 + 8 * fq;
        float rsv[8];
#pragma unroll
        for (int q = 0; q < 8; ++q) rsv[q] = row_ss_lds(lds, wr * 64 + fr + (q >> 2) * HALF + (q & 3) * 16);
#pragma unroll
        for (int q = 0; q < 8; ++q) rsv[q] = __builtin_amdgcn_rsqf(rsv[q] * (1.0f / 1024.0f) + RMS_EPS);
#pragma unroll
        for (int ai = 0; ai < 2; ++ai)
#pragma unroll
            for (int m = 0; m < 4; ++m) {
                const int row = row0 + ai * HALF + m * 16;
                const float rs = rsv[ai * 4 + m];
                const f32x2 c1 = {-rs * LOG2E, -rs * LOG2E}, rs2 = {rs * rs, rs * rs}, one = {1.0f, 1.0f};
                unsigned wv[4];
#pragma unroll
                for (int n = 0; n < 2; ++n)
#pragma unroll
                    for (int p = 0; p < 2; ++p) {
                        const f32x2 av = {acc[ai][0][m][n][2 * p], acc[ai][0][m][n][2 * p + 1]}, bv = {acc[ai][1][m][n][2 * p], acc[ai][1][m][n][2 * p + 1]};
                        const f32x2 t = av * c1;
                        f32x2 e; e[0] = __builtin_amdgcn_exp2f(t[0]); e[1] = __builtin_amdgcn_exp2f(t[1]);
                        const f32x2 d = e + one;
                        f32x2 r; r[0] = __builtin_amdgcn_rcpf(d[0]); r[1] = __builtin_amdgcn_rcpf(d[1]);
                        const f32x2 hv = (av * bv) * (r * rs2);
                        wv[2 * n + p] = cvt_pk_bf16(hv[0], hv[1]);
                    }
                u32x4 w; w.x = wv[0]; w.y = wv[1]; w.z = wv[2]; w.w = wv[3];
                *(u32x4*)(H + (size_t)row * ldh + hcol) = w;
            }
    }
};


struct EpiNull {
    static constexpr bool PERM = true, AFTER_DRAIN = false, PF = false;
    __device__ __forceinline__ void operator()(const f32x4 (&acc)[2][2][4][2], const Unit& u, int wr, int wc, int fr, int fq) const {
#pragma unroll
        for (int ai = 0; ai < 2; ++ai)
#pragma unroll
            for (int bj = 0; bj < 2; ++bj)
#pragma unroll
                for (int m = 0; m < 4; ++m)
#pragma unroll
                    for (int n = 0; n < 2; ++n) asm volatile("" :: "v"(acc[ai][bj][m][n]));
    }
};

template <class Epi, class Sched, bool ALIGN_EPI = false, bool SP2 = false>
__device__ __forceinline__ void gemm_phase(PG8_LAS unsigned char* lds, const Gemm g, const Sched& S, const Epi& E) {
    const int tid = threadIdx.x, wid = __builtin_amdgcn_readfirstlane(tid >> 6), lane = tid & 63, wr = wid >> 2, wc = wid & 3, fr = lane & 15, fq = lane >> 4;
    const int K = g.K, nt = K / BK;
    unsigned voffA[2], voffB[2];
#pragma unroll
    for (int i = 0; i < 2; ++i) { int R, C; stage_rc(tid * 16 + i * 8192, R, C); const int Rb = Epi::PERM ? ((R & ~31) + perm32(R & 31)) : R;
        voffA[i] = (unsigned)(R * K + C) * 2u; voffB[i] = (unsigned)(Rb * K + C) * 2u; }
    const size_t kstep = (size_t)(BK * 2);
    const size_t hstep = (size_t)HALF * K * 2;
    const size_t tstep = 2 * hstep;
    const unsigned ldsw = (unsigned)wid * 1024u;
    const int aoff = lds_byte(wr * 64 + fr, fq * 8), boff = lds_byte(wc * 32 + fr, fq * 8);
#define PG8_SA(b, h) (((b) * 2 + (h)) * HTB)
#define PG8_SB(b, h) ((4 + (b) * 2 + (h)) * HTB)
#define PG8_STAGE(bufoff, gbase, voff) do { _Pragma("unroll") for (int _i = 0; _i < 2; ++_i) \
        __builtin_amdgcn_global_load_lds((const unsigned*)((const char*)(gbase) + (voff)[_i]), (PG8_LAS unsigned*)(lds + (bufoff) + ldsw + _i * 8192), 16, 0, 0); } while (0)
#define PG8_LDA(dst, b, h) do { _Pragma("unroll") for (int m = 0; m < 4; ++m) _Pragma("unroll") for (int k = 0; k < 2; ++k) dst[m][k] = *(const PG8_LAS bf16x8*)(lds + PG8_SA(b, h) + aoff + m * 2048 + k * 1024); } while (0)
#define PG8_LDB(dst, b, h) do { _Pragma("unroll") for (int n = 0; n < 2; ++n) _Pragma("unroll") for (int k = 0; k < 2; ++k) dst[n][k] = *(const PG8_LAS bf16x8*)(lds + PG8_SB(b, h) + boff + n * 2048 + k * 1024); } while (0)
#define PG8_MMA(ai, bj, At, Bt) do { __builtin_amdgcn_s_setprio(1); _Pragma("unroll") for (int m = 0; m < 4; ++m) _Pragma("unroll") for (int n = 0; n < 2; ++n) _Pragma("unroll") for (int k = 0; k < 2; ++k) \
        acc[ai][bj][m][n] = __builtin_amdgcn_mfma_f32_16x16x32_bf16(Bt[n][k], At[m][k], acc[ai][bj][m][n], 0, 0, 0); __builtin_amdgcn_s_setprio(0); } while (0)
#define PG8_WAIT_V(n) asm volatile("s_waitcnt vmcnt(" #n ")" ::: "memory")
#define PG8_WAIT_L(n) asm volatile("s_waitcnt lgkmcnt(" #n ")" ::: "memory")
#define PG8_BAR __builtin_amdgcn_s_barrier()
#define PG8_SCHED __builtin_amdgcn_sched_barrier(0)
    Unit cur, nxt; int ui = 0;
    if (!S.next(0, cur)) return;
    f32x4 acc[2][2][4][2];
#pragma unroll
    for (int a = 0; a < 2; ++a)
#pragma unroll
        for (int b = 0; b < 2; ++b)
#pragma unroll
            for (int m = 0; m < 4; ++m)
#pragma unroll
                for (int n = 0; n < 2; ++n) acc[a][b][m][n] = (f32x4){0.f, 0.f, 0.f, 0.f};
    bf16x8 At[4][2], B0[2][2], B1[2][2];
    const char* cA = (const char*)g.A + (size_t)cur.pm * tstep; const char* cB = (const char*)g.Bt + (size_t)cur.pn * tstep;
    S.a_ready(cur);
    if constexpr (SP2) {
        PG8_STAGE(PG8_SB(0, 0), cB, voffB); PG8_STAGE(PG8_SB(0, 1), cB + hstep, voffB); PG8_STAGE(PG8_SA(0, 0), cA, voffA); PG8_STAGE(PG8_SA(0, 1), cA + hstep, voffA);
        if (wr == 1) PG8_BAR;
        PG8_WAIT_V(2); PG8_BAR;
        PG8_STAGE(PG8_SB(1, 0), cB + kstep, voffB); PG8_STAGE(PG8_SA(1, 0), cA + kstep, voffA); PG8_STAGE(PG8_SB(1, 1), cB + hstep + kstep, voffB);
        PG8_WAIT_V(6); PG8_BAR;
    } else {
        PG8_STAGE(PG8_SB(0, 0), cB, voffB); PG8_STAGE(PG8_SA(0, 0), cA, voffA); PG8_STAGE(PG8_SB(0, 1), cB + hstep, voffB); PG8_STAGE(PG8_SA(0, 1), cA + hstep, voffA);
        if (wr == 1) PG8_BAR;
        PG8_WAIT_V(4); PG8_BAR;
        PG8_STAGE(PG8_SB(1, 0), cB + kstep, voffB); PG8_STAGE(PG8_SA(1, 0), cA + kstep, voffA); PG8_STAGE(PG8_SB(1, 1), cB + hstep + kstep, voffB);
        PG8_WAIT_V(6); PG8_BAR;
    }
    for (;;) {
        const bool has_next = S.next(ui + 1, nxt);
        const char* nA = has_next ? (const char*)g.A + (size_t)nxt.pm * tstep : cA; const char* nB = has_next ? (const char*)g.Bt + (size_t)nxt.pn * tstep : cB;
        for (int t = 0; t < nt; t += 2) {
            const bool last = (t == nt - 2);
            const char* a1 = cA + (size_t)(t + 1) * kstep;
            const char* a2 = last ? nA : cA + (size_t)(t + 2) * kstep; const char* b2 = last ? nB : cB + (size_t)(t + 2) * kstep;
            const char* a3 = a2 + kstep; const char* b3 = b2 + kstep;
            if (last && has_next) S.a_ready(nxt);
            if constexpr (SP2) {
            PG8_LDB(B0, 0, 0); PG8_LDB(B1, 0, 1); PG8_SCHED; PG8_LDA(At, 0, 0); PG8_STAGE(PG8_SA(1, 1), a1 + hstep, voffA);
            bool pf = false; if constexpr (Epi::PF) pf = (t == nt - 4);
            if (pf) { if constexpr (Epi::PF) E.prefetch(cur, wid, lane); PG8_WAIT_V(9); } else { PG8_WAIT_V(8); }
            PG8_WAIT_L(0); PG8_BAR; PG8_MMA(0, 0, At, B0); PG8_MMA(0, 1, At, B1); PG8_BAR; PG8_SCHED;
            PG8_LDA(At, 0, 1); PG8_STAGE(PG8_SB(0, 0), b2, voffB); PG8_STAGE(PG8_SB(0, 1), b2 + hstep, voffB); PG8_STAGE(PG8_SA(0, 0), a2, voffA);
            if (pf) { PG8_WAIT_V(9); } else { PG8_WAIT_V(8); }
            PG8_WAIT_L(0); PG8_BAR; PG8_MMA(1, 0, At, B0); PG8_MMA(1, 1, At, B1); PG8_BAR; PG8_SCHED;
            PG8_LDB(B0, 1, 0); PG8_LDB(B1, 1, 1); PG8_SCHED; PG8_LDA(At, 1, 0); PG8_STAGE(PG8_SA(0, 1), a2 + hstep, voffA);
            PG8_WAIT_V(8); PG8_WAIT_L(0); PG8_BAR; PG8_MMA(0, 0, At, B0); PG8_MMA(0, 1, At, B1); PG8_BAR; PG8_SCHED;
            PG8_LDA(At, 1, 1); PG8_STAGE(PG8_SB(1, 0), b3, voffB); PG8_STAGE(PG8_SB(1, 1), b3 + hstep, voffB); PG8_STAGE(PG8_SA(1, 0), a3, voffA);
            PG8_WAIT_V(8); PG8_WAIT_L(0); PG8_BAR; PG8_MMA(1, 0, At, B0); PG8_MMA(1, 1, At, B1); PG8_BAR; PG8_SCHED;
            } else {
            PG8_LDB(B0, 0, 0); PG8_SCHED; PG8_LDA(At, 0, 0); PG8_STAGE(PG8_SA(1, 1), a1 + hstep, voffA);
            PG8_WAIT_L(8); PG8_BAR; PG8_WAIT_L(0); PG8_MMA(0, 0, At, B0); PG8_BAR; PG8_SCHED;
            PG8_LDB(B1, 0, 1); PG8_STAGE(PG8_SB(0, 0), b2, voffB);
            PG8_BAR; PG8_WAIT_L(0); PG8_MMA(0, 1, At, B1); PG8_BAR;
            PG8_LDA(At, 0, 1); PG8_STAGE(PG8_SA(0, 0), a2, voffA);
            PG8_BAR; PG8_WAIT_L(0); PG8_MMA(1, 0, At, B0); PG8_BAR; PG8_SCHED;
            PG8_STAGE(PG8_SB(0, 1), b2 + hstep, voffB);
            PG8_WAIT_V(6); PG8_BAR; PG8_MMA(1, 1, At, B1); PG8_BAR;
            PG8_LDB(B0, 1, 0); PG8_SCHED; PG8_LDA(At, 1, 0); PG8_STAGE(PG8_SA(0, 1), a2 + hstep, voffA);
            PG8_WAIT_L(8); PG8_BAR; PG8_WAIT_L(0); PG8_MMA(0, 0, At, B0); PG8_BAR; PG8_SCHED;
            PG8_LDB(B1, 1, 1); PG8_STAGE(PG8_SB(1, 0), b3, voffB);
            PG8_BAR; PG8_WAIT_L(0); PG8_MMA(0, 1, At, B1); PG8_BAR;
            PG8_LDA(At, 1, 1); PG8_STAGE(PG8_SA(1, 0), a3, voffA);
            PG8_BAR; PG8_WAIT_L(0); PG8_MMA(1, 0, At, B0); PG8_BAR; PG8_SCHED;
            PG8_STAGE(PG8_SB(1, 1), b3 + hstep, voffB);
            PG8_WAIT_V(6); PG8_BAR; PG8_MMA(1, 1, At, B1); PG8_BAR;
            }
        }
        if constexpr (ALIGN_EPI) { if (wr == 0) PG8_BAR; }
        if constexpr (!Epi::AFTER_DRAIN) { E(acc, cur, wr, wc, fr, fq); S.done(cur); }
        if (!has_next) break;
#pragma unroll
        for (int a = 0; a < 2; ++a)
#pragma unroll
            for (int b = 0; b < 2; ++b)
#pragma unroll
                for (int m = 0; m < 4; ++m)
#pragma unroll
                    for (int n = 0; n < 2; ++n) acc[a][b][m][n] = (f32x4){0.f, 0.f, 0.f, 0.f};
        cur = nxt; cA = nA; cB = nB; ++ui;
        if constexpr (ALIGN_EPI) { if (wr == 1) PG8_BAR; }
    }
    PG8_WAIT_V(0);
    if constexpr (!ALIGN_EPI) { if (wr == 0) PG8_BAR; }
    PG8_BAR;
    if constexpr (Epi::AFTER_DRAIN) { E.fused(acc, cur, wr, wc, fr, fq, lds, wid, lane); S.done(cur); }
#undef PG8_SA
#undef PG8_SB
#undef PG8_STAGE
#undef PG8_LDA
#undef PG8_LDB
#undef PG8_MMA
#undef PG8_WAIT_V
#undef PG8_WAIT_L
#undef PG8_BAR
#undef PG8_SCHED
}
}

#define GAS __attribute__((address_space(1)))
#define LAS __attribute__((address_space(3)))
typedef unsigned short bf16;
typedef unsigned v4u __attribute__((ext_vector_type(4)));
typedef float f32x4 __attribute__((ext_vector_type(4)));
typedef short bf16x8 __attribute__((ext_vector_type(8)));
typedef GAS unsigned gu32;
typedef GAS unsigned long long gu64;
#define RLX_AGENT __ATOMIC_RELAXED, __HIP_MEMORY_SCOPE_AGENT
#define LDS_WAIT() asm volatile("s_waitcnt lgkmcnt(0)" ::: "memory")
#define VM_WAIT() asm volatile("s_waitcnt vmcnt(0)" ::: "memory")
__device__ __forceinline__ unsigned long long rt() { return __builtin_amdgcn_s_memrealtime(); }
__device__ __forceinline__ unsigned f2bf(float f) { unsigned u = __builtin_bit_cast(unsigned, f); return (u + 0x7fffu + ((u >> 16) & 1u)) >> 16; }
__device__ __forceinline__ unsigned pk2(float lo, float hi) { return f2bf(lo) | (f2bf(hi) << 16); }

#define XB_TMO      128
#define XB_XCNT(j)  (256  + 64 * (j))
#define XB_XSUB(j)  (1280 + 64 * (j))
#define XB_XGEN(j)  (2304 + 64 * (j))
#define XB_TOP      3328
#define XB_TOPGEN   3392
#define XCD_BAR_WORDS 3456
#define XB_SPIN_CAP (1u << 18)

__device__ __forceinline__ unsigned xb_ld(unsigned* p)              { return __hip_atomic_load(p, __ATOMIC_RELAXED, __HIP_MEMORY_SCOPE_AGENT); }
__device__ __forceinline__ unsigned xb_add(unsigned* p, unsigned v) { return __hip_atomic_fetch_add(p, v, __ATOMIC_RELAXED, __HIP_MEMORY_SCOPE_AGENT); }
__device__ __forceinline__ unsigned xb_xcc_id() { return (unsigned)__builtin_amdgcn_s_getreg((3 << 11) | 20) & 0xFu; }
#define XB_SPIN(cond, bar) do { unsigned _sp = 0; while (cond) { __builtin_amdgcn_s_sleep(1); \
    if ((++_sp & 255u) == 0u) { if (xb_ld(&(bar)[XB_TMO])) break; if (_sp > XB_SPIN_CAP) { atomicAdd(&(bar)[XB_TMO], 1u); break; } } } } while (0)

struct XcdBarrier {
    unsigned* bar; unsigned x;
    volatile LAS unsigned* st;
};

__device__ __forceinline__ XcdBarrier xcd_barrier_post(unsigned* bar, volatile LAS unsigned* st) {
    XcdBarrier b; b.bar = bar; b.x = xb_xcc_id(); b.st = st;
    if (threadIdx.x == 0) (void)xb_add(&bar[XB_XCNT(b.x)], 1u);
    return b;
}
__device__ __forceinline__ void xcd_barrier_complete(unsigned* bar, unsigned x, unsigned& nloc, unsigned& nx) {
    const unsigned G = gridDim.x * gridDim.y * gridDim.z;
    unsigned sum, cnt, mine, sp = 0u;
    for (;;) {
        sum = 0u; cnt = 0u; mine = 0u;
#pragma unroll
        for (unsigned j = 0; j < 16; ++j) { const unsigned c = xb_ld(&bar[XB_XCNT(j)]); sum += c; cnt += (c > 0u) ? 1u : 0u; mine = (j == x) ? c : mine; }
        if (sum == G) break;
        __builtin_amdgcn_s_sleep(1);
        if ((++sp & 255u) == 0u) { if (xb_ld(&bar[XB_TMO])) break; if (sp > XB_SPIN_CAP) { atomicAdd(&bar[XB_TMO], 1u); break; } }
    }
    nloc = mine > 0u ? mine : 1u; nx = cnt > 0u ? cnt : 1u;
}

__device__ __forceinline__ void xcd_barrier(const XcdBarrier& b) {
    asm volatile("s_waitcnt vmcnt(0)" ::: "memory");
    __syncthreads();
    if (threadIdx.x == 0) {
        unsigned* bar = b.bar;
        __builtin_amdgcn_s_waitcnt(0);
        unsigned nloc = b.st[0], nx = b.st[1];
        if (nloc == 0u) { xcd_barrier_complete(bar, b.x, nloc, nx); b.st[0] = nloc; b.st[1] = nx; }
        const unsigned old = xb_add(&bar[XB_XSUB(b.x)], 1u);
        const unsigned gen = old / nloc;
        if (old + 1u == (gen + 1u) * nloc) {
            __builtin_amdgcn_fence(__ATOMIC_RELEASE, "agent");
            asm volatile("s_waitcnt vmcnt(0)" ::: "memory");
            const unsigned og = xb_add(&bar[XB_TOP], 1u);
            const unsigned tg = og / nx;
            if (og + 1u == (tg + 1u) * nx) xb_add(&bar[XB_TOPGEN], 1u);
            else XB_SPIN(xb_ld(&bar[XB_TOPGEN]) == tg, bar);
            __builtin_amdgcn_fence(__ATOMIC_ACQUIRE, "agent");
            xb_add(&bar[XB_XGEN(b.x)], 1u);
            asm volatile("s_waitcnt vmcnt(0)" ::: "memory");
        } else {
            XB_SPIN(xb_ld(&bar[XB_XGEN(b.x)]) == gen, bar);
            __builtin_amdgcn_fence(__ATOMIC_ACQUIRE, "agent");
            asm volatile("s_waitcnt vmcnt(0)" ::: "memory");
        }
    }
    __syncthreads();
}

constexpr int NWAVES = 8;
constexpr int NB = 16, SEQ = 2048, DM = 1024, M = NB * SEQ;
constexpr int EVW = 3080, N_IN = 3072, FFH = 2816, N_UP = 2 * FFH, N_QKV = 1536;
constexpr float LOG2E_F = 1.4426950408889634f;
constexpr size_t MiB = 1u << 20;
constexpr size_t WS_CTL = 0, CTL_ZERO_BYTES = 1 * MiB;
constexpr size_t WS_SSQ = 186 * MiB;
constexpr size_t WS_GT = 1 * MiB + 768 * 1024;
constexpr size_t WS_LF = 2 * MiB;
constexpr size_t WS_C2 = 3 * MiB;
constexpr size_t WS_W = 4 * MiB;
constexpr size_t WO_IN = 0, WO_EO = WO_IN + (size_t)N_IN * DM * 2, WO_UP0 = WO_EO + (size_t)DM * DM * 2, WO_DN0 = WO_UP0 + (size_t)N_UP * DM * 2,
                 WO_QKV = WO_DN0 + (size_t)DM * FFH * 2, WO_OO = WO_QKV + (size_t)N_QKV * DM * 2, WO_UP1 = WO_OO + (size_t)DM * DM * 2, WO_DN1 = WO_UP1 + (size_t)N_UP * DM * 2,
                 WO_END = WO_DN1 + (size_t)DM * FFH * 2;
static_assert(WO_END <= 46 * MiB, "weights");
constexpr size_t WS_XB = 50 * MiB;
constexpr size_t WS_R1 = 178 * MiB;
constexpr size_t WS_CKREC = 182 * MiB;
constexpr size_t WS_BIG = 306 * MiB;
constexpr size_t WS_MIX = 114 * MiB;
constexpr size_t WS_END = 498 * MiB;
constexpr int CW_BAR = 4096;
constexpr int CW_FOXQ = 24576;

constexpr int RING_OFF = 0, RING_BYTES = 131072;
constexpr int LDSCTL_OFF = 139264, MISC_OFF = LDSCTL_OFF + 320;
constexpr int LDS_BYTES = 147456;

__device__ const unsigned char kBucket[128] = {
    0, 1, 2, 3, 4, 5, 6, 7, 8, 9, 10, 11, 12, 13, 14, 15, 16, 16, 16, 17, 17, 18, 18, 18, 19, 19, 19, 20, 20, 20, 20, 21,
    21, 21, 21, 22, 22, 22, 22, 22, 23, 23, 23, 23, 23, 23, 24, 24, 24, 24, 24, 24, 25, 25, 25, 25, 25, 25, 25, 26, 26, 26, 26, 26,
    26, 26, 26, 27, 27, 27, 27, 27, 27, 27, 27, 27, 27, 28, 28, 28, 28, 28, 28, 28, 28, 28, 28, 29, 29, 29, 29, 29, 29, 29, 29, 29,
    29, 29, 29, 30, 30, 30, 30, 30, 30, 30, 30, 30, 30, 30, 30, 30, 30, 31, 31, 31, 31, 31, 31, 31, 31, 31, 31, 31, 31, 31, 31, 31};

struct Args {
    const float* in[25]; float* out; unsigned char* ws; int ph_lo, ph_hi, use_bar, rep_mask;
};

struct Frame {
    LAS unsigned char* lds;
    volatile LAS unsigned* MISC;
    gu32* ctl;
    int tid, lane, wave, vcu, G;
};

__device__ __forceinline__ float wave_sum(float v) {
#pragma unroll
    for (int o = 1; o < 64; o <<= 1) v += __shfl_xor(v, o);
    return v;
}
__device__ __forceinline__ float bf2f(bf16 v) { return __builtin_bit_cast(float, (unsigned)v << 16); }

enum { MAP_PLAIN = 0, MAP_IN = 1, MAP_HEADPERM = 2, MAP_GATE = 3, MAP_UP = 4 };
__device__ __forceinline__ int dest_row(int kind, int col) {
    if (kind == MAP_PLAIN) return col;
    if (kind == MAP_GATE) return 256 * (col >> 7) + (col & 127);
    if (kind == MAP_UP) return 256 * (col >> 7) + 128 + (col & 127);
    int c = col;
    if (kind == MAP_IN) { if (col >= 1536 && col < 1544) return -1; if (col >= 1544) c = col - 8; }
    const int t = c & ~255, w = c & 255, g = w >> 6, b = (w >> 5) & 1, j = w & 31;
    return t + 128 * b + 32 * g + j;
}
struct WJob { const float* W; const float* gain; bf16* WT; int K, N, kind, start, pad; };
struct TrRegs { f32x4 r[8]; float g[8]; int k0, n0, job; };
constexpr int NJOBS = 10;
__device__ __forceinline__ void tr_load(TrRegs& R, const LAS WJob* jobs, int it, int lane) {
    int jb = 0;
#pragma unroll
    for (int q = 1; q < NJOBS; ++q) if (it >= jobs[q].start) jb = q;
    const LAS WJob& J = jobs[jb];
    const int local = it - J.start, N = J.N, nblk = (N + 31) >> 5, kb = local / nblk, nb = local - kb * nblk;
    R.k0 = 64 * kb; R.n0 = 32 * nb; R.job = jb;
    const float* W = J.W; const float* gain = J.gain;
    const int cc = R.n0 + 4 * (lane & 7);
#pragma unroll
    for (int i = 0; i < 8; ++i) { const int kk = R.k0 + (lane >> 3) + 8 * i;
        R.r[i] = (f32x4){0.f, 0.f, 0.f, 0.f}; if (cc < N) R.r[i] = *(const GAS f32x4*)(W + (size_t)kk * N + cc);
        R.g[i] = 1.0f; if (gain) R.g[i] = gain[kk]; }
}
__device__ __forceinline__ void tr_store(const TrRegs& R, const LAS WJob* jobs, LAS float* scr, int lane) {
    const LAS WJob& J = jobs[R.job];
    const int N = J.N, K = J.K, kind = J.kind; bf16* WT = J.WT;
#pragma unroll
    for (int i = 0; i < 8; ++i) { LAS float* s = scr + ((lane >> 3) + 8 * i) * 33 + 4 * (lane & 7); const float g = R.g[i];
        s[0] = R.r[i].x * g; s[1] = R.r[i].y * g; s[2] = R.r[i].z * g; s[3] = R.r[i].w * g; }
    LDS_WAIT(); asm volatile("" ::: "memory");
    const int c = lane & 7;
#pragma unroll
    for (int j = 0; j < 4; ++j) { const int n = (lane >> 3) + 8 * j; const LAS float* s = scr + (8 * c) * 33 + n;
        v4u o; o.x = pk2(s[0 * 33], s[1 * 33]); o.y = pk2(s[2 * 33], s[3 * 33]); o.z = pk2(s[4 * 33], s[5 * 33]); o.w = pk2(s[6 * 33], s[7 * 33]);
        const int col = R.n0 + n; const int dr = (col < N) ? dest_row(kind, col) : -1;
        if (dr >= 0) *(GAS v4u*)(WT + (size_t)dr * K + R.k0 + 8 * c) = o; }
    LDS_WAIT(); asm volatile("" ::: "memory");
}

struct XRegs { f32x4 v[4]; };
__device__ __forceinline__ void x_load(XRegs& X, const float* x, int m, int lane) {
    const GAS f32x4* xr = (const GAS f32x4*)(x + (size_t)m * DM) + lane;
#pragma unroll
    for (int j = 0; j < 4; ++j) X.v[j] = xr[64 * j];
}
__device__ __forceinline__ void x_row(const XRegs& X, int m, const LAS float* wfT, float* ssq, float* lf, bf16* xb, const float* bfg, int lane) {
    float s = 0.f;
#pragma unroll
    for (int j = 0; j < 4; ++j) s += (X.v[j].x * X.v[j].x + X.v[j].y * X.v[j].y) + (X.v[j].z * X.v[j].z + X.v[j].w * X.v[j].w);
    float ff[8];
#pragma unroll
    for (int h = 0; h < 8; ++h) { float acc = 0.f;
#pragma unroll
        for (int j = 0; j < 4; ++j) { const f32x4 w = *(const LAS f32x4*)(wfT + h * DM + 256 * j + 4 * lane); acc += (X.v[j].x * w.x + X.v[j].y * w.y) + (X.v[j].z * w.z + X.v[j].w * w.w); }
        ff[h] = acc; }
    GAS unsigned long long* o8 = (GAS unsigned long long*)(xb + (size_t)m * DM) + lane;
#pragma unroll
    for (int j = 0; j < 4; ++j) o8[64 * j] = (unsigned long long)pk2(X.v[j].x, X.v[j].y) | ((unsigned long long)pk2(X.v[j].z, X.v[j].w) << 32);
    const bool b5 = lane & 32, b4 = lane & 16, b3 = lane & 8;
    float t4[4];
#pragma unroll
    for (int i = 0; i < 4; ++i) { const float keep = b5 ? ff[i + 4] : ff[i], give = b5 ? ff[i] : ff[i + 4]; t4[i] = keep + __shfl_xor(give, 32); }
    float t2[2];
#pragma unroll
    for (int i = 0; i < 2; ++i) { const float keep = b4 ? t4[i + 2] : t4[i], give = b4 ? t4[i] : t4[i + 2]; t2[i] = keep + __shfl_xor(give, 16); }
    float t1;
    { const float keep = b3 ? t2[1] : t2[0], give = b3 ? t2[0] : t2[1]; t1 = keep + __shfl_xor(give, 8); }
    t1 += __shfl_xor(t1, 4); t1 += __shfl_xor(t1, 2); t1 += __shfl_xor(t1, 1);
    s = wave_sum(s);
    const float rs = __builtin_amdgcn_rsqf(s * (1.0f / DM) + 1e-6f);
    if ((lane & 7) == 0) { const int h = lane >> 3; const float z = t1 * rs + bfg[h]; lf[(size_t)m * 8 + h] = fminf(z, 0.f) - log1pf(expf(-fabsf(z))); }
    if (lane == 1) { *(f32x4*)(ssq + (size_t)m * 4) = (f32x4){s, 0.f, 0.f, 0.f}; }
}

__device__ __forceinline__ void p0_prologue(Frame& F, const Args& a) {
    unsigned char* ws = a.ws;
    bf16* wb = (bf16*)(ws + WS_W);
    LAS float* scr = (LAS float*)(F.lds + RING_OFF + F.wave * 16384);
    LAS WJob* jobs = (LAS WJob*)(F.lds + LDSCTL_OFF + 1024);
    const int gw = F.vcu * NWAVES + F.wave, NGW = F.G * NWAVES;
    int total;
    {
        int st = 0;
#define SETJOB(q, Wp, Kk, Nn, gainp, WTp, kindv) { if (F.tid == 0) { jobs[q].W = (Wp); jobs[q].gain = (gainp); jobs[q].WT = (WTp); jobs[q].K = (Kk); jobs[q].N = (Nn); jobs[q].kind = (kindv); jobs[q].start = st; jobs[q].pad = 0; } \
            st += ((Kk) / 64) * (((Nn) + 31) / 32); }
        SETJOB(0, a.in[3], DM, EVW, a.in[2], (bf16*)((char*)wb + WO_IN), MAP_IN)
        SETJOB(1, a.in[14], DM, DM, (const float*)nullptr, (bf16*)((char*)wb + WO_EO), MAP_PLAIN)
        SETJOB(2, a.in[22], DM, FFH, a.in[21], (bf16*)((char*)wb + WO_UP0), MAP_GATE)
        SETJOB(3, a.in[23], DM, FFH, a.in[21], (bf16*)((char*)wb + WO_UP0), MAP_UP)
        SETJOB(4, a.in[24], FFH, DM, (const float*)nullptr, (bf16*)((char*)wb + WO_DN0), MAP_PLAIN)
        SETJOB(5, a.in[16], DM, N_QKV, a.in[15], (bf16*)((char*)wb + WO_QKV), MAP_HEADPERM)
        SETJOB(6, a.in[20], DM, DM, (const float*)nullptr, (bf16*)((char*)wb + WO_OO), MAP_PLAIN)
        SETJOB(7, a.in[22] + (size_t)DM * FFH, DM, FFH, a.in[21] + DM, (bf16*)((char*)wb + WO_UP1), MAP_GATE)
        SETJOB(8, a.in[23] + (size_t)DM * FFH, DM, FFH, a.in[21] + DM, (bf16*)((char*)wb + WO_UP1), MAP_UP)
        SETJOB(9, a.in[24] + (size_t)FFH * DM, FFH, DM, (const float*)nullptr, (bf16*)((char*)wb + WO_DN1), MAP_PLAIN)
#undef SETJOB
        total = st;
    }
    __syncthreads();
    {
        TrRegs A, B;
        int it = gw;
        if (it < total) tr_load(A, jobs, it, F.lane);
        while (it < total) {
            const int n1 = it + NGW;
            if (n1 < total) tr_load(B, jobs, n1, F.lane);
            tr_store(A, jobs, scr, F.lane);
            if (n1 >= total) break;
            const int n2 = n1 + NGW;
            if (n2 < total) tr_load(A, jobs, n2, F.lane);
            tr_store(B, jobs, scr, F.lane);
            it = n2;
        }
    }
    if (F.vcu == 0) {
        float* gt = (float*)(ws + WS_GT);
        for (int t = F.tid; t < 18 * 64; t += NWAVES * 64) {
            const int tile = t >> 6, e = t & 63; float val;
            if (tile < 12) { const int tt = tile >> 1, kind = tt % 3, grp = tt / 3;
                const float q0 = a.in[5][e], k0 = a.in[6][e], q1 = a.in[7][e], k1 = a.in[8][e];
                const float qv = grp == 0 ? q0 : q1, kv = grp == 0 ? k0 : k1;
                val = kind == 0 ? qv * (0.125f * LOG2E_F) : (kind == 1 ? kv : 1.0f); }
            else { const int pn = tile - 12; const float qv = a.in[17][e], kv = a.in[18][e]; val = pn < 4 ? qv * (0.125f * LOG2E_F) : (pn == 4 ? kv : 1.0f); }
            gt[t] = val;
        }
    }
    __syncthreads();
    LAS float* wfT = (LAS float*)(F.lds + RING_OFF);
    for (int i = F.tid; i < 8 * DM; i += NWAVES * 64) { const int k = i >> 3, h = i & 7; wfT[h * DM + k] = a.in[3][(size_t)k * EVW + 1536 + h] * a.in[2][k]; }
    __syncthreads();
    {
        float* ssq = (float*)(ws + WS_SSQ); float* lf = (float*)(ws + WS_LF); bf16* xb = (bf16*)(ws + WS_XB);
        const float* x = a.in[0]; const float* bfg = a.in[4];
        XRegs A, B;
        int m = gw;
        if (m < M) x_load(A, x, m, F.lane);
        while (m < M) {
            const int m1 = m + NGW;
            if (m1 < M) x_load(B, x, m1, F.lane);
            x_row(A, m, wfT, ssq, lf, xb, bfg, F.lane);
            if (m1 >= M) break;
            const int m2 = m1 + NGW;
            if (m2 < M) x_load(A, x, m2, F.lane);
            x_row(B, m1, wfT, ssq, lf, xb, bfg, F.lane);
            m = m2;
        }
    }
}

__device__ __forceinline__ void cumsum_phase(Frame& F, const Args& a) {
    if (F.vcu >= NB * 8) return;
    const int b = F.vcu >> 3, h = F.vcu & 7;
    const float* lf = (const float*)(a.ws + WS_LF); float* c2 = (float*)(a.ws + WS_C2) + (size_t)F.vcu * SEQ;
    LAS float* wt = (LAS float*)(F.lds + RING_OFF);
    float v[4]; float run = 0.f;
#pragma unroll
    for (int i = 0; i < 4; ++i) { run += lf[((size_t)b * SEQ + 4 * F.tid + i) * 8 + h]; v[i] = run; }
    float inc = run;
#pragma unroll
    for (int o = 1; o < 64; o <<= 1) { const float t = __shfl_up(inc, o); if (F.lane >= o) inc += t; }
    if (F.lane == 63) wt[F.wave] = inc;
    __syncthreads();
    float base = 0.f;
    for (int w = 0; w < F.wave; ++w) base += wt[w];
    const float off = base + inc - run;
    f32x4 o; o.x = (v[0] + off) * LOG2E_F; o.y = (v[1] + off) * LOG2E_F; o.z = (v[2] + off) * LOG2E_F; o.w = (v[3] + off) * LOG2E_F;
    *(f32x4*)(c2 + 4 * F.tid) = o;
    {
        v4u* rec = (v4u*)(a.ws + WS_CKREC) + (size_t)F.vcu * SEQ + 4 * F.tid;
        const float vals[4] = {o.x, o.y, o.z, o.w};
#pragma unroll
        for (int i = 0; i < 4; ++i) { const float nv = -vals[i]; const unsigned hi16 = f2bf(nv); const float hif = __builtin_bit_cast(float, hi16 << 16); const unsigned lo16 = f2bf(nv - hif);
            v4u r; r.x = hi16 | (lo16 << 16); r.y = 0u; r.z = 0u; r.w = 0u; rec[i] = r; }
    }
    __syncthreads();
}

namespace att {
typedef short bf16x8 __attribute__((ext_vector_type(8)));
typedef short s16x4 __attribute__((ext_vector_type(4)));
typedef short v4i16_t __attribute__((ext_vector_type(4)));
typedef float f32x16 __attribute__((ext_vector_type(16)));
typedef float f32x4v __attribute__((ext_vector_type(4)));
typedef unsigned u32x4v __attribute__((ext_vector_type(4)));
typedef int i32x4v __attribute__((ext_vector_type(4)));
typedef __attribute__((address_space(3))) unsigned char* lptr;
typedef __attribute__((address_space(3))) const unsigned char* lcptr;
typedef float f32x2_t __attribute__((ext_vector_type(2))); typedef __bf16 bf16x2_t __attribute__((ext_vector_type(2)));

constexpr int OFF_CK = 98304, OFF_WSF = 101376, OFF_LUT = 141312, OFF_LUT_SWA = 49152, OFF_OST = 106496;
constexpr int LUTN = 320, LUTZ = 94;
constexpr float THR = 16.0f;
constexpr float NEG_INF = -INFINITY;

__device__ __forceinline__ int crow(int r, int hi) { return (r & 3) + 8 * (r >> 2) + 4 * hi; }
__device__ __forceinline__ unsigned cvtpk(float lo, float hi) { f32x2_t v = {lo, hi}; bf16x2_t b = __builtin_convertvector(v, bf16x2_t); return __builtin_bit_cast(unsigned, b); }
__device__ __forceinline__ s16x4 vtr(lcptr p) { return __builtin_bit_cast(s16x4, __builtin_amdgcn_ds_read_tr16_b64_v4i16((__attribute__((address_space(3))) v4i16_t*)p)); }
__device__ __forceinline__ float xhalf_max(float m) { auto rr = __builtin_amdgcn_permlane32_swap(__float_as_uint(m), __float_as_uint(m), false, false); return fmaxf(__uint_as_float(rr[0]), __uint_as_float(rr[1])); }
__device__ __forceinline__ float xhalf_sum(float m) { auto rr = __builtin_amdgcn_permlane32_swap(__float_as_uint(m), __float_as_uint(m), false, false); return __uint_as_float(rr[0]) + __uint_as_float(rr[1]); }

__device__ __forceinline__ void load_q(bf16x8 (&q)[4], const bf16* qp, int pitch, int lane) {
    const int r32 = lane & 31, hi = lane >> 5;
#pragma unroll
    for (int d0 = 0; d0 < 4; ++d0) q[d0] = *(const bf16x8*)(qp + (unsigned)(r32 * pitch + d0 * 16 + hi * 8));
}
struct UnitDesc {
    const bf16* q;
    const bf16* k; const bf16* k2; const bf16* v;
    int pitch;
    const float* c2;
    const float* c2f;
    const bf16* nk; const bf16* nk2; const bf16* nv; const float* nc2;
    int t0, t1;
    int q0;
    unsigned* qctr; int qbase, qlnb, qgb, qug; const bf16* qproj; const char* qck;
};
__device__ __forceinline__ void fox_decode(int idx, int lnb, int gb, int& qb, int& b, int& h) {
    const int per = 16 << lnb, s = idx >> (4 + lnb), r = idx & (per - 1);
    qb = 7 - (r >> (1 + lnb)); b = gb + (r & ((1 << lnb) - 1)); h = 2 * s + ((r >> lnb) & 1);
}

__device__ __forceinline__ float max3f(float a, float b, float c) { float r; asm("v_max3_f32 %0, %1, %2, %3" : "=v"(r) : "v"(a), "v"(b), "v"(c)); return r; }
__device__ __forceinline__ float max2f(float a, float b) { float r; asm("v_max_f32_e32 %0, %1, %2" : "=v"(r) : "v"(a), "v"(b)); return r; }
__device__ __forceinline__ float rowmax32(const f32x16& p0, const f32x16& p1) {
    float a = max3f(p0[0], p0[1], p1[0]), b = max3f(p0[2], p0[3], p1[1]); a = max3f(a, p1[2], p1[3]);
#pragma unroll
    for (int r = 4; r < 16; r += 4) { a = max3f(a, p0[r], p0[r + 1]); b = max3f(b, p0[r + 2], p0[r + 3]); a = max3f(a, p1[r], p1[r + 1]); b = max3f(b, p1[r + 2], p1[r + 3]); }
    return xhalf_max(max2f(a, b));
}
__device__ __forceinline__ void causal_mask(f32x16& p0, f32x16& p1, int mb) {
#pragma unroll
    for (int r = 0; r < 16; ++r) { if ((r & 3) + 8 * (r >> 2) > mb) p0[r] = NEG_INF; if ((r & 3) + 8 * (r >> 2) + 32 > mb) p1[r] = NEG_INF; }
}
__device__ __forceinline__ void lut_bias(f32x16& p0, f32x16& p1, __attribute__((address_space(3))) const float* lutx, int dc0) {
    __attribute__((address_space(3))) const float* pb = lutx + (dc0 + LUTZ - 59);
#pragma unroll
    for (int r = 0; r < 16; ++r) { const int c = (r & 3) + 8 * (r >> 2); p0[r] += pb[59 - c]; p1[r] += pb[59 - c - 32]; }
}

__device__ __forceinline__ void glds16(const void* gsrc, unsigned lds_dst) { unsigned keep;
    asm volatile("s_mov_b32 %0, m0\n\ts_mov_b32 m0, %2\n\ts_nop 0\n\tglobal_load_lds_dwordx4 %1, off\n\ts_mov_b32 m0, %0" : "=&s"(keep) : "v"(gsrc), "s"(lds_dst) : "memory"); }
__device__ __forceinline__ void glds4(const void* gsrc, unsigned lds_dst) { unsigned keep;
    asm volatile("s_mov_b32 %0, m0\n\ts_mov_b32 m0, %2\n\ts_nop 0\n\tglobal_load_lds_dword %1, off\n\ts_mov_b32 m0, %0" : "=&s"(keep) : "v"(gsrc), "s"(lds_dst) : "memory"); }
#define ATT_WAIT_BAR(N) asm volatile("s_waitcnt vmcnt(" #N ") lgkmcnt(0)\n\ts_barrier" ::: "memory")

template <int VAR, int DVB, bool STREAM = false, bool GRP2 = false>
__device__ __forceinline__ void unit_loop_p(LAS unsigned char* lds, const UnitDesc& U, int qw, f32x16 (&o)[DVB], float& mhat, float& l,
                                            __attribute__((address_space(3))) const float* lut, float b31, int kmap, int wave, int lane, unsigned long long (&stamp_acc)[6], unsigned long long& stamp_last, const bf16x8 (&qreg)[4], int stream_dma = -1, bool pre_issued = false, int next_t1 = -1) {
    constexpr int SLOT = (VAR == 1) ? 32768 : 16384, VOFF = (VAR == 1) ? 16384 : 8192;
    const int r32 = lane & 31, hi = lane >> 5;
    const int qpos = qw + r32;
    const lptr qlds = (lptr)lds + OFF_OST + wave * 4096 + lane * 16;
#define P_QF(d0) ((VAR != 1) ? qf[d0] : *(const __attribute__((address_space(3))) bf16x8*)(qlds + (d0) * 1024))
    const unsigned ksrc = (unsigned)(lane * U.pitch + wave * 8), vsrc = (unsigned)((16 * (wave & 3) + (lane >> 2)) * U.pitch + (wave >> 2) * 32 + (lane & 3) * 8);
    const unsigned lds0 = (unsigned)(uintptr_t)lds;
    const unsigned dstw = lds0 + (unsigned)wave * 1024u;
    const int t0 = U.t0, t1 = U.t1;
    int tend = t1;
#define P_TILE2(i, T1) ((VAR == 0) ? ((T1) - (i)) : (i))
#define P_TILE(i) P_TILE2(i, t1)
#define P_INR(i) (P_TILE(i) >= t0w && P_TILE(i) <= t1w)
    int t0w = t0; const int t1w = ((qw + 31) >> 6) < t1 ? ((qw + 31) >> 6) : t1;
    if (VAR == 2) { while (64 * t0w + 63 <= qw - 128) ++t0w; }
    __attribute__((address_space(3))) float* wsf = (__attribute__((address_space(3))) float*)((lptr)lds + OFF_WSF + wave * 256);
    const lcptr kfb = (lcptr)lds + kmap * 8192 + hi * 1024 + r32 * 16;
    const lcptr vfb = (lcptr)lds + VOFF + ((lane >> 4) & 1) * 32 + (lane & 3) * 8 + (4 * hi + ((lane & 15) >> 2)) * 64;
#define P_SLOT(u) ((int)((unsigned)(u) % (STREAM ? 6u : 3u)) * SLOT)
#define P_DMAK3(u, T1, KB, KB2, CB) do { const unsigned to_ = (unsigned)(P_TILE2(u, T1) * 64 * U.pitch) + ksrc; const unsigned sd_ = (unsigned)__builtin_amdgcn_readfirstlane((int)(dstw + (unsigned)P_SLOT(u))); \
        glds16((KB) + to_, sd_); if (VAR == 1) glds16((KB2) + to_, sd_ + 8192u); \
        if (VAR == 0) { if (wave == 0) glds16((const char*)(CB) + (size_t)(P_TILE2(u, T1) * 64 + lane) * 16, (unsigned)__builtin_amdgcn_readfirstlane((int)(lds0 + OFF_CK + ((unsigned)(u) % 3u) * 1024u))); } } while (0)
#define P_DMAK2(u, T1) P_DMAK3(u, T1, U.k, U.k2, U.c2)
#define P_DMAK(u) P_DMAK2(u, t1)
#define P_DMAV3(u, T1, VB) do { const unsigned to_ = (unsigned)(P_TILE2(u, T1) * 64 * U.pitch) + vsrc; const unsigned sd_ = (unsigned)__builtin_amdgcn_readfirstlane((int)(dstw + (unsigned)(P_SLOT(u) + VOFF))); \
        glds16((VB) + to_, sd_); if (VAR == 1) glds16((VB) + to_ + 64, sd_ + 8192u); } while (0)
#define P_DMAV2(u, T1) P_DMAV3(u, T1, U.v)
#define P_DMAV(u) P_DMAV2(u, t1)
#define P_SB() __builtin_amdgcn_sched_barrier(0)
    if (!STREAM) { if (!pre_issued) { P_DMAK(t0); P_DMAV(t0); if (t0 + 1 <= t1) P_DMAK(t0 + 1); } }
#pragma unroll
    for (int d0 = 0; d0 < 4; ++d0) { if (VAR == 1) *(__attribute__((address_space(3))) bf16x8*)(qlds + d0 * 1024) = qreg[d0]; }
    bf16x8 qf[4];
#pragma unroll
    for (int d0 = 0; d0 < 4; ++d0) qf[d0] = qreg[d0];
    if (STREAM) { if (stream_dma >= 0) { P_DMAK(stream_dma); P_DMAV(stream_dma); } }
    int qtok = 0x7fffffff;
    if (!STREAM) {
    ATT_WAIT_BAR(0);
    if (VAR == 0) { if (U.qctr != nullptr && threadIdx.x == 0) qtok = U.qbase + (int)__hip_atomic_fetch_add(U.qctr, 1u, __ATOMIC_RELAXED, __HIP_MEMORY_SCOPE_AGENT); }
    if (t0 + 2 <= t1) P_DMAK(t0 + 2);
    }
    f32x16 negm; bf16x8 q5 = (bf16x8){0, 0, 0, 0, 0, 0, 0, 0}; if (hi == 0) { q5[0] = (short)0x3F80; q5[1] = (short)0x3F80; }
    f32x16 PA0, PA1, PB0, PB1;
    PA0 = f32x16{}; PA1 = f32x16{}; PB0 = f32x16{}; PB1 = f32x16{};

#define P_CINIT(u) do { float ci_ = -mhat; if (VAR == 1) { if (qw - (64 * (u) + 63) >= 128) ci_ += b31; } _Pragma("unroll") for (int r_ = 0; r_ < 16; ++r_) negm[r_] = ci_; } while (0)
#define P_K5A(u) (*(const __attribute__((address_space(3))) bf16x8*)((lcptr)lds + OFF_CK + (int)((unsigned)(u) % 3u) * 1024 + r32 * 16))
#define P_K5B(u) (*(const __attribute__((address_space(3))) bf16x8*)((lcptr)lds + OFF_CK + (int)((unsigned)(u) % 3u) * 1024 + 512 + r32 * 16))
#define P_QK(P0, P1, u) do { lcptr kb_ = kfb + P_SLOT(u); asm volatile("" : "+v"(kb_)); P_CINIT(P_TILE(u)); const f32x16 z_ = negm; \
        _Pragma("unroll") for (int d0_ = 0; d0_ < 4; ++d0_) { \
            const bf16x8 k0_ = *(const __attribute__((address_space(3))) bf16x8*)(kb_ + d0_ * 2048), k1_ = *(const __attribute__((address_space(3))) bf16x8*)(kb_ + d0_ * 2048 + 512); \
            const bf16x8 q_ = P_QF(d0_); P0 = __builtin_amdgcn_mfma_f32_32x32x16_bf16(k0_, q_, d0_ == 0 ? z_ : P0, 0, 0, 0); P1 = __builtin_amdgcn_mfma_f32_32x32x16_bf16(k1_, q_, d0_ == 0 ? z_ : P1, 0, 0, 0); } \
        if (VAR == 0) { P0 = __builtin_amdgcn_mfma_f32_32x32x16_bf16(P_K5A(u), q5, P0, 0, 0, 0); P1 = __builtin_amdgcn_mfma_f32_32x32x16_bf16(P_K5B(u), q5, P1, 0, 0, 0); } } while (0)
#define P_SM1(P0, P1, u, isfirst) do { \
        asm volatile("s_nop 15\n\ts_nop 7" : "+v"(P0), "+v"(P1));        \
        if (VAR == 0) { if (64 * P_TILE(u) + 63 > qw) causal_mask(P0, P1, qpos - 64 * P_TILE(u) - 4 * hi); } \
        else { if ((VAR == 2) || (qw - (64 * (u) + 63) < 128)) lut_bias(P0, P1, lut, qpos - 64 * (u) - 4 * hi); } \
        const float rm_ = rowmax32(P0, P1); \
        if ((isfirst) || __any(rm_ > THR)) { float dl_ = (isfirst) ? rm_ : fmaxf(rm_, 0.f); if (dl_ == NEG_INF) dl_ = 0.f; mhat += dl_; fres_ = __builtin_amdgcn_exp2f(-dl_); resc_ = true; \
            _Pragma("unroll") for (int r_ = 0; r_ < 16; ++r_) { P0[r_] -= dl_; P1[r_] -= dl_; } } } while (0)
    {
        bool resc_ = false; float fres_ = 1.f;
        if (P_INR(t0)) {
            P_QK(PA0, PA1, t0);
            P_SM1(PA0, PA1, t0, VAR != 2);
#pragma unroll
            for (int r = 0; r < 16; ++r) { PA0[r] = __builtin_amdgcn_exp2f(PA0[r]); PA1[r] = __builtin_amdgcn_exp2f(PA1[r]); }
            if (VAR == 2 && resc_) { l *= fres_; }
        }
    }
    if (!STREAM) asm volatile("s_waitcnt lgkmcnt(0)\n\ts_barrier" ::: "memory");
#define P_GAPA(PC0, PC1, i) do { if ((i) < 4) { sacc_ += (PC0[4 * (i)] + PC0[4 * (i) + 1]) + (PC0[4 * (i) + 2] + PC0[4 * (i) + 3]); pw_[(i) >> 1][2 * ((i) & 1)] = cvtpk(PC0[4 * (i)], PC0[4 * (i) + 1]); pw_[(i) >> 1][2 * ((i) & 1) + 1] = cvtpk(PC0[4 * (i) + 2], PC0[4 * (i) + 3]); } \
        else { sacc_ += (PC1[4 * ((i) - 4)] + PC1[4 * ((i) - 4) + 1]) + (PC1[4 * ((i) - 4) + 2] + PC1[4 * ((i) - 4) + 3]); pw_[(i) >> 1][2 * ((i) & 1)] = cvtpk(PC1[4 * ((i) - 4)], PC1[4 * ((i) - 4) + 1]); pw_[(i) >> 1][2 * ((i) & 1) + 1] = cvtpk(PC1[4 * ((i) - 4) + 2], PC1[4 * ((i) - 4) + 3]); } } while (0)
#define P_EXP4(PN0, PN1, j) do { if ((j) < 4) { _Pragma("unroll") for (int e_ = 0; e_ < 4; ++e_) PN0[4 * (j) + e_] = __builtin_amdgcn_exp2f(PN0[4 * (j) + e_]); } \
        else { _Pragma("unroll") for (int e_ = 0; e_ < 4; ++e_) PN1[4 * ((j) - 4) + e_] = __builtin_amdgcn_exp2f(PN1[4 * ((j) - 4) + e_]); } } while (0)
#if defined(PROBE_ADD_MFMA)
#define PROBE_MFMA8(a_, b_, c_, d_, qa, qb) do { f32x16 dm_ = f32x16{}; dm_ = __builtin_amdgcn_mfma_f32_32x32x16_bf16(a_, qa, dm_, 0, 0, 0); dm_ = __builtin_amdgcn_mfma_f32_32x32x16_bf16(b_, qa, dm_, 0, 0, 0); \
        dm_ = __builtin_amdgcn_mfma_f32_32x32x16_bf16(c_, qb, dm_, 0, 0, 0); dm_ = __builtin_amdgcn_mfma_f32_32x32x16_bf16(d_, qb, dm_, 0, 0, 0); dm_ = __builtin_amdgcn_mfma_f32_32x32x16_bf16(a_, qb, dm_, 0, 0, 0); \
        dm_ = __builtin_amdgcn_mfma_f32_32x32x16_bf16(b_, qb, dm_, 0, 0, 0); dm_ = __builtin_amdgcn_mfma_f32_32x32x16_bf16(c_, qa, dm_, 0, 0, 0); dm_ = __builtin_amdgcn_mfma_f32_32x32x16_bf16(d_, qa, dm_, 0, 0, 0); asm volatile("" :: "v"(dm_)); } while (0)
#else
#define PROBE_MFMA8(a_, b_, c_, d_, qa, qb) do {} while (0)
#endif
#if defined(PROBE_ADD_EXP)
#define PROBE_EXP4(PN0, PN1, j) do { _Pragma("unroll") for (int e_ = 0; e_ < 4; ++e_) { float x_ = ((j) < 4 ? PN0[4 * ((j) & 3) + e_] : PN1[4 * ((j) & 3) + e_]); asm volatile("" : "+v"(x_)); x_ = __builtin_amdgcn_exp2f(x_); asm volatile("" :: "v"(x_)); } } while (0)
#else
#define PROBE_EXP4(PN0, PN1, j) do {} while (0)
#endif
#if defined(PROBE_ADD_BAR)
#define PROBE_BAR() asm volatile("s_waitcnt lgkmcnt(0)\n\ts_barrier" ::: "memory")
#else
#define PROBE_BAR() do {} while (0)
#endif
#if defined(PROBE_STAMP)
#define P_STAMP(k) do { __builtin_amdgcn_sched_barrier(0); unsigned long long ts_; asm volatile("s_memtime %0\n\ts_waitcnt lgkmcnt(0)" : "=s"(ts_) :: "memory"); __builtin_amdgcn_sched_barrier(0); stamp_acc[k] += ts_ - stamp_last; stamp_last = ts_; } while (0)
#else
#define P_STAMP(k) do {} while (0)
#endif
    __attribute__((address_space(3))) int* pflags = (__attribute__((address_space(3))) int*)((lptr)lds + OFF_WSF + 2048);
#define P_PRUNE_VOTE(t) do { if (VAR == 0) { int ok_ = 1; const int i2_ = (t) + 2; \
            if (i2_ <= t1) {   \
                const unsigned w_ = *(const __attribute__((address_space(3))) unsigned*)((lcptr)lds + OFF_CK + (int)((unsigned)((t) + 1) % 3u) * 1024); \
                const float nb_ = __builtin_bit_cast(float, w_ << 16) + __builtin_bit_cast(float, w_ & 0xffff0000u); \
                const bool st_ = (P_TILE((t) + 1) <= t1w); ok_ = (st_ && __all(mhat - b31 - nb_ > 31.0f)) ? 1 : 0; } \
            if (lane == 0) pflags[((t) & 1) * 8 + wave] = ok_; } } while (0)
#define P_PRUNE_READ(t) do { if (VAR == 0) { const i32x4v fa_ = *(const __attribute__((address_space(3))) i32x4v*)(pflags + ((t) & 1) * 8), fb_ = *(const __attribute__((address_space(3))) i32x4v*)(pflags + ((t) & 1) * 8 + 4); \
            const int all_ = fa_[0] & fa_[1] & fa_[2] & fa_[3] & fb_[0] & fb_[1] & fb_[2] & fb_[3]; \
            if (__builtin_amdgcn_readfirstlane(all_) && (t) + 1 < tend) tend = (t) + 1; } } while (0)
#if defined(PROBE_CYC)
#define P_CNT() do { stamp_acc[0] += 1; unsigned long long ts_; asm volatile("s_memtime %0\n\ts_waitcnt lgkmcnt(0)" : "=s"(ts_) :: "memory"); if (stamp_last) stamp_acc[2] += ts_ - stamp_last; stamp_last = ts_; } while (0)
#elif defined(PROBE_STEPS)
#define P_CNT() do { stamp_acc[0] += 1; } while (0)
#else
#define P_CNT() do {} while (0)
#endif
#define P_PHASEB(PW, TV, PX0, PX1, DOEXP) do { \
        lcptr vb_ = vfb + P_SLOT(TV); asm volatile("" : "+v"(vb_)); \
        s16x4 vl_[4], vh_[4]; \
        _Pragma("unroll") for (int q_ = 0; q_ < 4; ++q_) { vl_[q_] = vtr(vb_ + q_ * 1024); vh_[q_] = vtr(vb_ + q_ * 1024 + 512); } \
        P_SB(); \
        _Pragma("unroll") for (int j_ = 0; j_ < DVB * 4; ++j_) { \
            const int d_ = j_ >> 2, ks_ = j_ & 3; \
            const bf16x8 vf_ = (bf16x8){vl_[ks_][0], vl_[ks_][1], vl_[ks_][2], vl_[ks_][3], vh_[ks_][0], vh_[ks_][1], vh_[ks_][2], vh_[ks_][3]}; \
            o[d_] = __builtin_amdgcn_mfma_f32_32x32x16_bf16(__builtin_bit_cast(bf16x8, PW[ks_]), vf_, o[d_], 0, 0, 0); \
            if (j_ + 4 < DVB * 4) { const int dn_ = (j_ + 4) >> 2, dof_ = (dn_ >> 1) * 8192 + (dn_ & 1) * 4096 + ks_ * 1024; vl_[ks_] = vtr(vb_ + dof_); vh_[ks_] = vtr(vb_ + dof_ + 512); } \
            if (DOEXP) { if (DVB == 2) { P_EXP4(PX0, PX1, j_); } else { if ((j_ & 1) == 0) { P_EXP4(PX0, PX1, j_ >> 1); } } } \
            P_SB(); } \
        asm volatile("" : "+v"(PX0), "+v"(PX1));        \
    } while (0)
#define P_RESCALE(F_) do { l *= (F_); if (hi == 0) wsf[r32] = (F_); asm volatile("s_waitcnt lgkmcnt(0)" ::: "memory"); \
        _Pragma("unroll") for (int r_ = 0; r_ < 16; ++r_) { const float fr_ = wsf[crow(r_, hi)]; _Pragma("unroll") for (int d_ = 0; d_ < DVB; ++d_) o[d_][r_] *= fr_; } } while (0)
#define P_STEP_BAR(t) do { if (!STREAM) { if (fullq_) { if (VAR == 0) { if (wave == 0) { ATT_WAIT_BAR(2); } else { ATT_WAIT_BAR(1); } } else if (VAR == 1) { ATT_WAIT_BAR(2); } else { ATT_WAIT_BAR(1); } } else { ATT_WAIT_BAR(0); } } \
        P_PRUNE_READ(t); } while (0)
#define P_STEP(PC0, PC1, PN0, PN1, t) do { \
        P_CNT(); \
        const bool curv_ = P_INR(t), nxtv_ = ((t) + 1 <= tend) && P_INR((t) + 1); \
        const bool fullq_ = ((t) + 3 <= t1); \
          \
        if (!curv_) { asm volatile("; tile not needed by this wave: zero probabilities" ::: "memory"); PC0 = f32x16{}; PC1 = f32x16{}; }     \
        if (!STREAM) { if ((t) + 1 <= t1) P_DMAV((t) + 1); }        \
        float sacc_ = 0.f; u32x4v pw_[4]; bool resc_ = false; float fres_ = 1.f; \
        { \
            lcptr kb_ = kfb + P_SLOT((t) + 1); asm volatile("" : "+v"(kb_)); P_CINIT(P_TILE((t) + 1)); const f32x16 z_ = negm; \
            bf16x8 ka_ = *(const __attribute__((address_space(3))) bf16x8*)(kb_), kb2_ = *(const __attribute__((address_space(3))) bf16x8*)(kb_ + 512); \
            bf16x8 kc_ = *(const __attribute__((address_space(3))) bf16x8*)(kb_ + 2048), kd_ = *(const __attribute__((address_space(3))) bf16x8*)(kb_ + 2048 + 512); \
            bf16x8 qa_ = P_QF(0), qb_ = P_QF(1); \
            P_SB(); \
            PN0 = __builtin_amdgcn_mfma_f32_32x32x16_bf16(ka_, qa_, z_, 0, 0, 0); ka_ = *(const __attribute__((address_space(3))) bf16x8*)(kb_ + 4096); P_GAPA(PC0, PC1, 0); P_SB(); \
            PN1 = __builtin_amdgcn_mfma_f32_32x32x16_bf16(kb2_, qa_, z_, 0, 0, 0); qa_ = P_QF(2); kb2_ = *(const __attribute__((address_space(3))) bf16x8*)(kb_ + 4096 + 512); P_GAPA(PC0, PC1, 1); P_SB(); \
            PN0 = __builtin_amdgcn_mfma_f32_32x32x16_bf16(kc_, qb_, PN0, 0, 0, 0); kc_ = *(const __attribute__((address_space(3))) bf16x8*)(kb_ + 6144); P_GAPA(PC0, PC1, 2); P_SB(); \
            PN1 = __builtin_amdgcn_mfma_f32_32x32x16_bf16(kd_, qb_, PN1, 0, 0, 0); qb_ = P_QF(3); kd_ = *(const __attribute__((address_space(3))) bf16x8*)(kb_ + 6144 + 512); P_GAPA(PC0, PC1, 3); P_SB(); \
            PN0 = __builtin_amdgcn_mfma_f32_32x32x16_bf16(ka_, qa_, PN0, 0, 0, 0); P_GAPA(PC0, PC1, 4); P_SB(); \
            PN1 = __builtin_amdgcn_mfma_f32_32x32x16_bf16(kb2_, qa_, PN1, 0, 0, 0); P_GAPA(PC0, PC1, 5); P_SB(); \
            PN0 = __builtin_amdgcn_mfma_f32_32x32x16_bf16(kc_, qb_, PN0, 0, 0, 0); P_GAPA(PC0, PC1, 6); P_SB(); \
            PN1 = __builtin_amdgcn_mfma_f32_32x32x16_bf16(kd_, qb_, PN1, 0, 0, 0); P_GAPA(PC0, PC1, 7); P_SB(); \
            if (VAR == 0) { PN0 = __builtin_amdgcn_mfma_f32_32x32x16_bf16(P_K5A((t) + 1), q5, PN0, 0, 0, 0); PN1 = __builtin_amdgcn_mfma_f32_32x32x16_bf16(P_K5B((t) + 1), q5, PN1, 0, 0, 0); } \
            asm volatile("" : "+v"(pw_[0]), "+v"(pw_[1]), "+v"(pw_[2]), "+v"(pw_[3]), "+v"(sacc_));        \
        } \
        l += sacc_; \
        if (!STREAM) { if (fullq_) P_DMAK((t) + 3); }        \
        if (nxtv_) P_SM1(PN0, PN1, (t) + 1, (VAR == 1) ? ((t) + 1 == t0w) : ((VAR == 0) && (P_TILE((t) + 1) == t1w))); \
        P_PRUNE_VOTE(t); \
        if (GRP2) P_STEP_BAR(t);        \
        P_PHASEB(pw_, t, PN0, PN1, true); \
        if (resc_) P_RESCALE(fres_); \
        if (!GRP2) P_STEP_BAR(t); \
    } while (0)
    for (int t = t0; t <= tend; t += 2) {
        P_STEP(PA0, PA1, PB0, PB1, t);
        if (t + 1 <= tend) P_STEP(PB0, PB1, PA0, PA1, t + 1);
    }
    int nt1_ = next_t1; const bf16* nk_ = U.nk; const bf16* nk2_ = U.nk2; const bf16* nv_ = U.nv; const float* nc2_ = U.nc2;
    __attribute__((address_space(3))) int* dynw = (__attribute__((address_space(3))) int*)((lptr)lds + OFF_WSF + 2048 + 128);
    if (VAR == 0) { if (U.qctr != nullptr && threadIdx.x == 0) dynw[0] = qtok; }
    if (!STREAM) asm volatile("s_waitcnt lgkmcnt(0)\n\ts_barrier" ::: "memory");
    if (VAR == 0) { if (U.qctr != nullptr) { const int ni_ = __builtin_amdgcn_readfirstlane(dynw[0]);
            if (ni_ < U.qug) { int qb_, b_, h_; fox_decode(ni_, U.qlnb, U.qgb, qb_, b_, h_); nt1_ = 4 * qb_ + 3; nk_ = U.qproj + (size_t)b_ * SEQ * N_IN + 512 + h_ * 64; nk2_ = nk_; nv_ = nk_ + 512; nc2_ = (const float*)(U.qck + (size_t)(b_ * 8 + h_) * SEQ * 16); }
            else nt1_ = -1; } }
    if (!STREAM) { if (nt1_ >= 0) { P_DMAK3(0, nt1_, nk_, nk2_, nc2_); P_DMAV3(0, nt1_, nv_); if (nt1_ >= 1) P_DMAK3(1, nt1_, nk_, nk2_, nc2_); } }
    if (!STREAM && nt1_ < 0) asm volatile("s_waitcnt vmcnt(0)" ::: "memory");
#undef P_STEP_BAR
#undef P_PHASEB
#undef P_RESCALE
#undef P_TILE
#undef P_TILE2
#undef P_DMAK2
#undef P_DMAK3
#undef P_DMAV3
#undef P_DMAV2
#undef P_INR
#undef P_PRUNE_VOTE
#undef P_PRUNE_READ
#undef P_SLOT
#undef P_DMAK
#undef P_DMAV
#undef P_SB
#undef P_QK
#undef P_SM1
#undef P_CINIT
#undef P_K5A
#undef P_K5B
#undef P_GAPA
#undef P_EXP4
#undef P_STEP
#undef P_QF
}

template <int DVB> __device__ __forceinline__ void normalize_o(f32x16 (&o)[DVB], float l, __attribute__((address_space(3))) float* wsf, int r32, int hi) {
    const float lt = xhalf_sum(l);
    if (hi == 0) wsf[32 + r32] = __builtin_amdgcn_rcpf(lt);
    asm volatile("s_waitcnt lgkmcnt(0)" ::: "memory");
#pragma unroll
    for (int r = 0; r < 16; ++r) { const float il = wsf[32 + crow(r, hi)];
#pragma unroll
        for (int d = 0; d < DVB; ++d) o[d][r] *= il; }
}
template <int DVB> __device__ __forceinline__ void store_o(const f32x16 (&o)[DVB], LAS unsigned char* lds, int wave_slot, bf16* dst, int dpitch, int lane) {
    const int r32 = lane & 31, hi = lane >> 5;
    __attribute__((address_space(3))) bf16* stg = (__attribute__((address_space(3))) bf16*)((lptr)lds + OFF_OST) + wave_slot * (32 * 32 * DVB);
    constexpr int RW = 32 * DVB;
#pragma unroll
    for (int r = 0; r < 16; ++r) { const int orow = crow(r, hi);
#pragma unroll
        for (int d = 0; d < DVB; ++d) stg[orow * RW + d * 32 + r32] = (bf16)f2bf(o[d][r]); }
    asm volatile("s_waitcnt lgkmcnt(0)" ::: "memory");
    constexpr int CPR = RW / 8;
#pragma unroll
    for (int i = 0; i < (32 * CPR) / 64; ++i) { const int idx = i * 64 + lane, row = idx / CPR, ch = idx % CPR;
        const u32x4v v = *(const __attribute__((address_space(3))) u32x4v*)(stg + row * RW + ch * 8);
        *(u32x4v*)(dst + (unsigned)(row * dpitch + ch * 8)) = v; }
    asm volatile("s_waitcnt lgkmcnt(0)" ::: "memory");
}

__device__ __forceinline__ void attn0_fox(Frame& F, const Args& a) {
    const int wave = F.wave;
    unsigned long long stamp_acc[6] = {0, 0, 0, 0, 0, 0}; unsigned long long stamp_last = 0;
    unsigned char* ws = a.ws;
    const bf16* proj = (const bf16*)(ws + WS_BIG); bf16* mix = (bf16*)(ws + WS_MIX); const float* c2 = (const float*)(ws + WS_C2);
    __attribute__((address_space(3))) float* wsf = (__attribute__((address_space(3))) float*)((lptr)F.lds + OFF_WSF + wave * 256);
    __attribute__((address_space(3))) float* lutb = (__attribute__((address_space(3))) float*)((lptr)F.lds + OFF_LUT);
    float bqk; { float gq = 0.f, gk = 0.f; for (int i = 0; i < 64; ++i) { gq = fmaxf(gq, fabsf(a.in[5][i])); gk = fmaxf(gk, fabsf(a.in[6][i])); } bqk = 64.0f * 1.008f * (0.125f * LOG2E_F) * gq * gk; }
    const int lng = ((F.G & 7) == 0 && (F.G >> 3) <= 128) ? 3 : 0, gsz = F.G >> lng, lnb = 4 - lng, ug = 64 << lnb;
    const int g = F.vcu / gsz, gb = g << lnb;
    unsigned* qctr = (unsigned*)(F.ctl + CW_FOXQ) + g * 64;
    __attribute__((address_space(3))) int* dynw = (__attribute__((address_space(3))) int*)((lptr)F.lds + OFF_WSF + 2048 + 128);
    int cur = F.vcu - g * gsz, qg = g; bool first = true;
    const int ngr = 1 << lng;
#define FOX_QP(qb_, b_, h_) (proj + ((size_t)(b_) * SEQ + (qb_) * 256 + 32 * wave) * N_IN + (h_) * 64)
    bf16x8 qreg[4];
    if (cur < ug) { int qb, b, h; fox_decode(cur, lnb, gb, qb, b, h); load_q(qreg, FOX_QP(qb, b, h), N_IN, F.lane); }
#pragma unroll 1
    while (cur < ug) {
        const int cgb = qg << lnb;
        int qb, b, h; fox_decode(cur, lnb, cgb, qb, b, h);
        const size_t rowb = (size_t)b * SEQ; const int bh = b * 8 + h;
        int lane = F.lane; asm volatile("" : "+v"(lane));
        const int q0 = qb * 256, qw = q0 + 32 * wave;
        UnitDesc U; U.pitch = N_IN; U.q = nullptr; U.k = proj + rowb * N_IN + 512 + h * 64; U.k2 = U.k; U.v = proj + rowb * N_IN + 1024 + h * 64;
        U.c2 = (const float*)((const char*)(ws + WS_CKREC) + (size_t)bh * SEQ * 16); U.c2f = c2 + (size_t)bh * SEQ; U.t0 = 0; U.t1 = (q0 + 255) / 64; U.q0 = q0;
        U.nk = U.k; U.nk2 = U.k; U.nv = U.v; U.nc2 = U.c2;
        U.qctr = (unsigned*)(F.ctl + CW_FOXQ) + qg * 64; U.qbase = gsz; U.qlnb = lnb; U.qgb = cgb; U.qug = ug; U.qproj = proj; U.qck = (const char*)(ws + WS_CKREC);
        f32x16 o[2]; o[0] = f32x16{}; o[1] = f32x16{}; float mhat = 0.f, l = 0.f;
        if (wave >= 4) unit_loop_p<0, 2, false, true>(F.lds, U, qw, o, mhat, l, lutb, bqk, 0, wave, lane, stamp_acc, stamp_last, qreg, -1, !first, -1);
        else unit_loop_p<0, 2, false, false>(F.lds, U, qw, o, mhat, l, lutb, bqk, 0, wave, lane, stamp_acc, stamp_last, qreg, -1, !first, -1);
        int nxt = __builtin_amdgcn_readfirstlane(dynw[0]);
        int lane2 = F.lane; asm volatile("" : "+v"(lane2));
        if (nxt < ug) { int qbn, bn, hn; fox_decode(nxt, lnb, cgb, qbn, bn, hn); load_q(qreg, FOX_QP(qbn, bn, hn), N_IN, lane2); }
        normalize_o<2>(o, l, wsf, lane2 & 31, lane2 >> 5);
        store_o<2>(o, F.lds, wave, mix + (rowb + qw) * DM + h * 64, DM, lane2);
        asm volatile("s_waitcnt lgkmcnt(0)\n\ts_barrier" ::: "memory");
        first = false;
        if (nxt >= ug && ngr > 1) {
            for (int rnd = 0; rnd < ngr && nxt >= ug; ++rnd) {
                if (F.tid == 0) {
                    int best = -1; unsigned bc = 0xffffffffu;
                    for (int k = 0; k < ngr; ++k) { const unsigned c = __hip_atomic_load((unsigned*)(F.ctl + CW_FOXQ) + k * 64, __ATOMIC_RELAXED, __HIP_MEMORY_SCOPE_AGENT); if (c < bc) { bc = c; best = k; } }
                    int got = 0x7fffffff;
                    if (best >= 0 && gsz + (int)bc < ug) got = gsz + (int)__hip_atomic_fetch_add((unsigned*)(F.ctl + CW_FOXQ) + best * 64, 1u, __ATOMIC_RELAXED, __HIP_MEMORY_SCOPE_AGENT);
                    else best = -1;
                    dynw[2 + 2 * (rnd & 1)] = got; dynw[3 + 2 * (rnd & 1)] = best;
                }
                asm volatile("s_waitcnt vmcnt(0) lgkmcnt(0)\n\ts_barrier" ::: "memory");
                const int got = __builtin_amdgcn_readfirstlane(dynw[2 + 2 * (rnd & 1)]), vg = __builtin_amdgcn_readfirstlane(dynw[3 + 2 * (rnd & 1)]);
                if (vg < 0) break;
                if (got < ug) { nxt = got; qg = vg; }
            }
            if (nxt < ug) { int qbn, bn, hn; fox_decode(nxt, lnb, qg << lnb, qbn, bn, hn); load_q(qreg, FOX_QP(qbn, bn, hn), N_IN, F.lane); first = true; }
        }
        cur = nxt;
    }
#undef FOX_QP
#if defined(PROBE_STEPS)
    if (blockIdx.x == 0 && F.tid == 0) { ((float*)(a.ws + WS_GT))[2048] = 0.08f + 0.16f * ((float)stamp_acc[0] / (float)stamp_acc[1]); }
#endif
#if defined(PROBE_CYC)
    if (blockIdx.x == 0 && F.tid == 0) { ((float*)(a.ws + WS_GT))[2048] = 0.08f + 0.16f * (((float)stamp_acc[2] / (float)stamp_acc[0]) / 8000.0f); }
#endif
#if defined(PROBE_STAMP)
    if (blockIdx.x == 0 && F.tid == 0) { float tot = 0.f; for (int k = 0; k < 5; ++k) tot += (float)stamp_acc[k]; ((float*)(a.ws + WS_GT))[2048] = 0.08f + 0.16f * ((float)stamp_acc[PROBE_STAMP] / tot); }
#endif
}
__device__ __forceinline__ void attn0_diff(Frame& F, const Args& a) {
    const int wave = F.wave;
    unsigned long long stamp_acc[6] = {0, 0, 0, 0, 0, 0}; unsigned long long stamp_last = 0;
    unsigned char* ws = a.ws;
    const bf16* proj = (const bf16*)(ws + WS_BIG); bf16* mix = (bf16*)(ws + WS_MIX);
    __attribute__((address_space(3))) float* wsf = (__attribute__((address_space(3))) float*)((lptr)F.lds + OFF_WSF + wave * 256);
    __attribute__((address_space(3))) float* lutb = (__attribute__((address_space(3))) float*)((lptr)F.lds + OFF_LUT);
    for (int i = F.tid; i < 4 * LUTN; i += NWAVES * 64) { const int h = i / LUTN, e = i % LUTN, d = e - LUTZ; lutb[i] = d < 0 ? NEG_INF : a.in[1][(d < 128 ? kBucket[d] : 31) * 16 + h] * LOG2E_F; }
    __attribute__((address_space(3))) float* parm = lutb + 4 * LUTN;
    if (F.tid == 0) { float s1 = 0.f, s2 = 0.f; for (int i = 0; i < 64; ++i) { s1 += a.in[9][i] * a.in[10][i]; s2 += a.in[11][i] * a.in[12][i]; } parm[0] = expf(s1) - expf(s2) + 0.2f; }
    if (F.tid < 128) parm[4 + F.tid] = a.in[13][F.tid] * 0.8f;
    __syncthreads();
    for (int vv = F.vcu; vv < 256; vv += F.G) {
        const int bh = vv >> 2, b = bh >> 2, h = bh & 3, jj = vv & 3;
        const size_t rowb = (size_t)b * SEQ;
        const int mp = wave >> 2, qs = wave & 3;
#define DIFF_QB(i) (4 * (i) + ((((i) & 1) != 0) ? 3 - jj : jj))
#define DIFF_QP(i) (proj + (rowb + DIFF_QB(i) * 128 + 32 * qs) * N_IN + 1536 + h * 128 + mp * 64)
        bf16x8 qreg[4]; load_q(qreg, DIFF_QP(0), N_IN, F.lane);
#pragma unroll 1
        for (int i = 0; i < 4; ++i) {
            const int qb = DIFF_QB(i);
            int lane = F.lane; asm volatile("" : "+v"(lane));
            const int q0 = qb * 128, qw = q0 + 32 * qs;
            UnitDesc U; U.qctr = nullptr; U.pitch = N_IN; U.q = nullptr; U.k = proj + rowb * N_IN + 2048 + h * 128; U.k2 = U.k + 64; U.v = proj + rowb * N_IN + 2560 + h * 128;
            U.c2 = nullptr; U.c2f = nullptr; U.t0 = 0; U.t1 = (q0 + 127) / 64; U.q0 = q0; U.nk = U.k; U.nk2 = U.k2; U.nv = U.v; U.nc2 = nullptr;
            f32x16 o[4]; o[0] = f32x16{}; o[1] = f32x16{}; o[2] = f32x16{}; o[3] = f32x16{}; float mhat = 0.f, l = 0.f;
            { const int nt1 = (i + 1 < 4) ? (DIFF_QB(i + 1) * 128 + 127) / 64 : -1; const float b31v = lutb[h * LUTN + LUTZ + 128];
              unit_loop_p<1, 4, false, false>(F.lds, U, qw, o, mhat, l, lutb + h * LUTN, b31v, mp, wave, lane, stamp_acc, stamp_last, qreg, -1, i > 0, nt1); }
            int lane2 = F.lane; asm volatile("" : "+v"(lane2));
            if (i + 1 < 4) load_q(qreg, DIFF_QP(i + 1), N_IN, lane2);
            normalize_o<4>(o, l, wsf, lane2 & 31, lane2 >> 5);
            __attribute__((address_space(3))) unsigned* ex = (__attribute__((address_space(3))) unsigned*)((lptr)F.lds + 65536) + qs * 2048;
            if (mp == 1) {
#pragma unroll
                for (int d = 0; d < 4; ++d)
#pragma unroll
                    for (int r = 0; r < 8; ++r) ex[(d * 8 + r) * 64 + lane2] = cvtpk(o[d][2 * r], o[d][2 * r + 1]);
            }
            asm volatile("s_waitcnt lgkmcnt(0)\n\ts_barrier" ::: "memory");
            if (mp == 0) {
                const float lam = parm[0]; float sub[4];
#pragma unroll
                for (int d = 0; d < 4; ++d) sub[d] = parm[4 + d * 32 + (lane2 & 31)];
                float ss[16];
#pragma unroll
                for (int r = 0; r < 16; ++r) ss[r] = 0.f;
#pragma unroll
                for (int d = 0; d < 4; ++d)
#pragma unroll
                    for (int r = 0; r < 8; ++r) { const unsigned w = ex[(d * 8 + r) * 64 + lane2];
                        const float v0 = o[d][2 * r] - lam * __builtin_bit_cast(float, w << 16), v1 = o[d][2 * r + 1] - lam * __builtin_bit_cast(float, w & 0xffff0000u);
                        o[d][2 * r] = v0; o[d][2 * r + 1] = v1; ss[2 * r] += v0 * v0; ss[2 * r + 1] += v1 * v1; }
#pragma unroll
                for (int r = 0; r < 16; ++r) {
                    float s = ss[r];
                    s += __shfl_xor(s, 1); s += __shfl_xor(s, 2); s += __shfl_xor(s, 4); s += __shfl_xor(s, 8); s += __shfl_xor(s, 16);
                    const float rn = __builtin_amdgcn_rsqf(s * (1.0f / 128.0f) + 1e-6f);
#pragma unroll
                    for (int d = 0; d < 4; ++d) o[d][r] *= rn * sub[d];
                }
                store_o<4>(o, F.lds, qs, mix + (rowb + qw) * DM + 512 + h * 128, DM, lane2);
            }
            asm volatile("s_waitcnt lgkmcnt(0)\n\ts_barrier" ::: "memory");
        }
#undef DIFF_QB
#undef DIFF_QP
    }
}

__device__ __forceinline__ void attn1_phase(Frame& F, const Args& a) {
    const int wave = F.wave;
    unsigned long long stamp_acc[6] = {0, 0, 0, 0, 0, 0}; unsigned long long stamp_last = 0;
    unsigned char* ws = a.ws;
    const bf16* qkv = (const bf16*)(ws + WS_BIG); bf16* mix = (bf16*)(ws + WS_MIX);
    __attribute__((address_space(3))) float* wsf = (__attribute__((address_space(3))) float*)((lptr)F.lds + OFF_WSF + wave * 256);
    __attribute__((address_space(3))) float* lutb = (__attribute__((address_space(3))) float*)((lptr)F.lds + OFF_LUT);
    const unsigned lds0 = (unsigned)(uintptr_t)F.lds;
    for (int vv = F.vcu; vv < 256; vv += F.G) {
        const int bk = vv >> 2, b = bk >> 2, kvh = bk & 3, qb0 = 8 * (vv & 3), qbl = qb0 + 7;
        const size_t rowb = (size_t)b * SEQ;
        __syncthreads();
        for (int i = F.tid; i < 4 * LUTN; i += NWAVES * 64) { const int h = kvh * 4 + i / LUTN, e = i % LUTN, d = e - LUTZ; lutb[i] = (d < 0 || d >= 128) ? NEG_INF : a.in[1][kBucket[d] * 16 + h] * LOG2E_F; }
        const bf16* kbase = qkv + rowb * N_QKV + 1024 + kvh * 64; const bf16* vbase = qkv + rowb * N_QKV + 1280 + kvh * 64;
#define SWA_DMA(t) do { int ln_ = F.lane; asm volatile("" : "+v"(ln_)); \
            const unsigned ks_ = (unsigned)(((t) * 64 + ln_) * N_QKV + wave * 8), vs_ = (unsigned)(((t) * 64 + 16 * (wave & 3) + (ln_ >> 2)) * N_QKV + (wave >> 2) * 32 + (ln_ & 3) * 8); \
            const unsigned sd_ = (unsigned)__builtin_amdgcn_readfirstlane((int)(lds0 + (unsigned)wave * 1024u + ((unsigned)(t) % 6u) * 16384u)); \
            glds16(kbase + ks_, sd_); glds16(vbase + vs_, sd_ + 8192u); } while (0)
        { const int ta = qb0 >= 2 ? qb0 - 2 : 0, tb = qb0 + 2;
          for (int t = ta; t <= tb; ++t) SWA_DMA(t); }
        asm volatile("s_waitcnt vmcnt(0)" ::: "memory");
        __syncthreads();
        const int g = wave >> 1, head = kvh * 4 + g;
#define SWA_QP(i) (qkv + (rowb + (qb0 + (i)) * 64 + 32 * (wave & 1)) * N_QKV + head * 64)
        bf16x8 qreg[4]; load_q(qreg, SWA_QP(0), N_QKV, F.lane);
#pragma unroll 1
        for (int i = 0; i < 8; ++i) {
            int lane = F.lane; asm volatile("" : "+v"(lane));
            const int qb = qb0 + i, q0 = qb * 64, qw = q0 + 32 * (wave & 1);
            UnitDesc U; U.qctr = nullptr; U.pitch = N_QKV; U.q = nullptr; U.k = kbase; U.k2 = kbase; U.v = vbase;
            U.c2 = nullptr; U.c2f = nullptr; U.t0 = qb >= 2 ? qb - 2 : 0; U.t1 = qb; U.q0 = q0; U.nk = kbase; U.nk2 = kbase; U.nv = vbase; U.nc2 = nullptr;
            f32x16 o[2]; o[0] = f32x16{}; o[1] = f32x16{};
            float mhat = a.in[19][head] * LOG2E_F, l = ((lane >> 5) == 0) ? 1.0f : 0.0f;
            unit_loop_p<2, 2, true>(F.lds, U, qw, o, mhat, l, lutb + g * LUTN, 0.f, 0, wave, lane, stamp_acc, stamp_last, qreg, (qb + 3 <= qbl) ? qb + 3 : -1);
            int lane2 = F.lane; asm volatile("" : "+v"(lane2));
            asm volatile("s_waitcnt vmcnt(0)" ::: "memory");
            if (i + 1 < 8) load_q(qreg, SWA_QP(i + 1), N_QKV, lane2);
            normalize_o<2>(o, l, wsf, lane2 & 31, lane2 >> 5);
            store_o<2>(o, F.lds, wave, mix + (rowb + qw) * DM + head * 64, DM, lane2);
            asm volatile("s_waitcnt lgkmcnt(0)\n\ts_barrier" ::: "memory");
        }
#undef SWA_QP
#undef SWA_DMA
    }
}
}

#if defined(PROBE_NOATOM)
#define PROBE_NOATOM_PTR ((float*)nullptr)
#else
#define PROBE_NOATOM_PTR (ssq + 4 * M)
#endif
#ifndef WGM_P1
#define WGM_P1 4
#endif
#ifndef WGM_P6
#define WGM_P6 4
#endif
#ifndef WGM_UP
#define WGM_UP 4
#endif
#ifndef WGM_OUT
#define WGM_OUT 4
#endif
#ifndef WGM_DN
#define WGM_DN 4
#endif
#ifndef ALIGN_SWIGLU
#define ALIGN_SWIGLU true
#endif
#ifndef ALIGN_QKV
#define ALIGN_QKV true
#endif
__global__ void __launch_bounds__(NWAVES * 64, 2) skel_fwd(Args args) {
    extern __shared__ __attribute__((aligned(16))) unsigned char lds[];
    Frame F;
    F.lds = (LAS unsigned char*)lds;
    F.MISC = (volatile LAS unsigned*)(F.lds + MISC_OFF);
    F.tid = threadIdx.x; F.lane = F.tid & 63; F.wave = __builtin_amdgcn_readfirstlane(F.tid >> 6);
    F.G = gridDim.x; { const int bx = blockIdx.x; F.vcu = (F.G % 8 == 0) ? (bx % 8) * (F.G / 8) + bx / 8 : bx; }
    unsigned char* ws = args.ws;
    F.ctl = (gu32*)(ws + WS_CTL);
    for (int u = F.tid; u < (LDS_BYTES - LDSCTL_OFF) / 4; u += NWAVES * 64) ((LAS unsigned*)(F.lds + LDSCTL_OFF))[u] = 0u;
    __syncthreads();
    XcdBarrier bar; bar.bar = (unsigned*)(F.ctl + CW_BAR); bar.x = 0; bar.st = nullptr;
    if (args.use_bar) bar = xcd_barrier_post((unsigned*)(F.ctl + CW_BAR), F.MISC + 8);
#if defined(PROBE_DOUBLE_BAR)
#define GRID_BAR() do { if (args.use_bar) { xcd_barrier(bar); xcd_barrier(bar); } } while (0)
#else
#define GRID_BAR() do { if (args.use_bar) xcd_barrier(bar); } while (0)
#endif
    const int lo = args.ph_lo, hi = args.ph_hi;
#ifndef PHASE_MASK
#define PHASE_MASK 0x7ff
#endif
#define IN(k) (((PHASE_MASK >> (k)) & 1) && lo <= (k) && (k) < hi)
#define BOTH(k) (IN(k) && IN((k) + 1))
#define NREP(k) (1 + ((REP_MASK >> (k)) & 1))
#define REPEAT(k) _Pragma("unroll") for (int rep = NREP(k) - 1; rep >= 0; --rep)
    bf16* wb = (bf16*)(ws + WS_W);
    float* ssq = (float*)(ws + WS_SSQ);
    bf16* xb = (bf16*)(ws + WS_XB); bf16* big = (bf16*)(ws + WS_BIG); bf16* mix = (bf16*)(ws + WS_MIX);
    const int G = F.G, cid = (int)blockIdx.x;

    if (IN(0)) { REPEAT(0) { p0_prologue(F, args); __syncthreads(); } if (BOTH(0)) GRID_BAR(); }
    if (IN(1)) {
        REPEAT(1) {
        cumsum_phase(F, args);
        pg8::Gemm g{xb, (const bf16*)((const char*)wb + WO_IN), M, N_IN, DM}; pg8::StaticOrder S; S.init(M, N_IN, G, cid, WGM_P1);
        pg8::EpiQKV<0> E{big, N_IN, ssq, (const float*)(ws + WS_GT), F.lds};
        pg8::gemm_phase<pg8::EpiQKV<0>, pg8::StaticOrder, ALIGN_QKV, true>(F.lds + RING_OFF, g, S, E);
        }
        if (BOTH(1)) GRID_BAR();
    }
    if (IN(2)) {
#if defined(PROBE_IMBAL)
#define IMB_BEGIN() unsigned long long tb_; asm volatile("s_memtime %0\n\ts_waitcnt lgkmcnt(0)" : "=s"(tb_) :: "memory")
#define IMB_END() do { __syncthreads(); unsigned long long te_; asm volatile("s_memtime %0\n\ts_waitcnt lgkmcnt(0)" : "=s"(te_) :: "memory"); if (F.tid == 0) { const unsigned d_ = (unsigned)(te_ - tb_); atomicMax((unsigned*)(F.ctl + 20000), d_); atomicAdd((unsigned*)(F.ctl + 20064), d_); } } while (0)
#else
#define IMB_BEGIN() do {} while (0)
#define IMB_END() do {} while (0)
#endif
        REPEAT(2) {
#if defined(PROBE_IMBAL) && PROBE_IMBAL == 1
            { IMB_BEGIN(); att::attn0_fox(F, args); IMB_END(); } att::attn0_diff(F, args);
#elif defined(PROBE_IMBAL) && PROBE_IMBAL == 2
            att::attn0_fox(F, args); { IMB_BEGIN(); att::attn0_diff(F, args); IMB_END(); }
#else
            att::attn0_diff(F, args); att::attn0_fox(F, args);
#endif
        }
        if (BOTH(2)) GRID_BAR();
    }
    if (IN(3)) {
        REPEAT(3) {
        pg8::Gemm g{mix, (const bf16*)((const char*)wb + WO_EO), M, DM, DM}; pg8::StaticOrder S; S.init(M, DM, G, cid, WGM_OUT);
#if defined(NULL_EPI_PROBE3)
        if (rep) { pg8::EpiNull E0; pg8::gemm_phase<pg8::EpiNull, pg8::StaticOrder, true, true>(F.lds + RING_OFF, g, S, E0); } else
#endif
        { pg8::EpiRes<false> E{xb, rep ? (bf16*)(ws + WS_R1) : xb, nullptr, rep ? ssq + 16 * M : ssq + 4 * M, (LAS float*)(F.lds + RING_BYTES)};
        pg8::gemm_phase<pg8::EpiRes<false>, pg8::StaticOrder, true, true>(F.lds + RING_OFF, g, S, E); }
        }
        if (BOTH(3)) GRID_BAR();
    }
    if (IN(4)) {
        REPEAT(4) {
        pg8::Gemm g{xb, (const bf16*)((const char*)wb + WO_UP0), M, N_UP, DM}; pg8::StaticOrder S; S.init(M, N_UP, G, cid, WGM_UP);
#if defined(NULL_EPI_PROBE)
        if (rep) { pg8::EpiNull E0; pg8::gemm_phase<pg8::EpiNull, pg8::StaticOrder, true, true>(F.lds + RING_OFF, g, S, E0); } else
#endif
        { pg8::EpiSwiGLU E{big, FFH, ssq + 4 * M, F.lds};
        pg8::gemm_phase<pg8::EpiSwiGLU, pg8::StaticOrder, ALIGN_SWIGLU, true>(F.lds + RING_OFF, g, S, E); }
        }
        if (BOTH(4)) GRID_BAR();
    }
    if (IN(5)) {
        REPEAT(5) {
        pg8::Gemm g{big, (const bf16*)((const char*)wb + WO_DN0), M, DM, FFH}; pg8::StaticOrder S; S.init(M, DM, G, cid, WGM_DN);
        pg8::EpiRes<false> E{xb, rep ? (bf16*)(ws + WS_R1) : xb, nullptr, rep ? ssq + 16 * M : ssq + 8 * M, (LAS float*)(F.lds + RING_BYTES)};
        pg8::gemm_phase<pg8::EpiRes<false>, pg8::StaticOrder, true, true>(F.lds + RING_OFF, g, S, E);
        }
        if (BOTH(5)) GRID_BAR();
    }
    if (IN(6)) {
        REPEAT(6) {
        pg8::Gemm g{xb, (const bf16*)((const char*)wb + WO_QKV), M, N_QKV, DM}; pg8::StaticOrder S; S.init(M, N_QKV, G, cid, WGM_P6);
        pg8::EpiQKV<1> E{big, N_QKV, ssq + 8 * M, (const float*)(ws + WS_GT) + 12 * 64, F.lds};
        pg8::gemm_phase<pg8::EpiQKV<1>, pg8::StaticOrder, ALIGN_QKV, true>(F.lds + RING_OFF, g, S, E);
        }
        if (BOTH(6)) GRID_BAR();
    }
    if (IN(7)) {
#if defined(PROBE_IMBAL) && PROBE_IMBAL == 3
        { IMB_BEGIN(); att::attn1_phase(F, args); IMB_END(); }
#else
        REPEAT(7) att::attn1_phase(F, args);
#endif
        if (BOTH(7)) GRID_BAR();
    }
    if (IN(8)) {
#if defined(PROBE_IMBAL)
        if (blockIdx.x == 0 && F.tid == 0) { const float mx_ = (float)__hip_atomic_load((unsigned*)(F.ctl + 20000), __ATOMIC_RELAXED, __HIP_MEMORY_SCOPE_AGENT), sm_ = (float)__hip_atomic_load((unsigned*)(F.ctl + 20064), __ATOMIC_RELAXED, __HIP_MEMORY_SCOPE_AGENT);
            ((float*)(ws + WS_GT))[2048] = 0.08f + 0.16f * (1.0f - sm_ / (mx_ * (float)gridDim.x)); }
#endif
        REPEAT(8) {
        pg8::Gemm g{mix, (const bf16*)((const char*)wb + WO_OO), M, DM, DM}; pg8::StaticOrder S; S.init(M, DM, G, cid, WGM_OUT);
        pg8::EpiRes<false> E{xb, rep ? (bf16*)(ws + WS_R1) : xb, nullptr, rep ? ssq + 16 * M : ssq + 12 * M, (LAS float*)(F.lds + RING_BYTES)};
        pg8::gemm_phase<pg8::EpiRes<false>, pg8::StaticOrder, true, true>(F.lds + RING_OFF, g, S, E);
        }
        if (BOTH(8)) GRID_BAR();
    }
    if (IN(9)) {
        REPEAT(9) {
        pg8::Gemm g{xb, (const bf16*)((const char*)wb + WO_UP1), M, N_UP, DM}; pg8::StaticOrder S; S.init(M, N_UP, G, cid, WGM_UP);
        pg8::EpiSwiGLU E{big, FFH, ssq + 12 * M, F.lds};
        pg8::gemm_phase<pg8::EpiSwiGLU, pg8::StaticOrder, ALIGN_SWIGLU, true>(F.lds + RING_OFF, g, S, E);
        }
        if (BOTH(9)) GRID_BAR();
    }
    if (IN(10)) {
        REPEAT(10) {
        pg8::Gemm g{big, (const bf16*)((const char*)wb + WO_DN1), M, DM, FFH}; pg8::StaticOrder S; S.init(M, DM, G, cid, WGM_DN);
        pg8::EpiRes<true> E{xb, nullptr, rep ? (float*)(ws + WS_R1) : args.out, (float*)(ws + WS_GT) + 2048, (LAS float*)(F.lds + RING_BYTES)};
        pg8::gemm_phase<pg8::EpiRes<true>, pg8::StaticOrder, true, true>(F.lds + RING_OFF, g, S, E);
        }
    }
#undef IN
#undef BOTH
#undef NREP
#undef REPEAT
#undef GRID_BAR
}

#if MK_MODE == 0
namespace simple {
constexpr int PP = N_IN;
__global__ __launch_bounds__(128) void fox_k(const bf16* __restrict__ proj, const float* __restrict__ c2, bf16* __restrict__ mix) {
    const int h = blockIdx.y, b = blockIdx.z, q0 = blockIdx.x * 128, qp = q0 + threadIdx.x;
    const size_t rb = (size_t)b * SEQ;
    const float* cc = c2 + (size_t)(b * 8 + h) * SEQ;
    float q[64], acc[64];
    const bf16* qr = proj + (rb + qp) * PP + h * 64;
#pragma unroll
    for (int d = 0; d < 64; ++d) { q[d] = bf2f(qr[d]); acc[d] = 0.f; }
    float m = -1e30f, l = 0.f;
    const int kend = q0 + 128;
    for (int k = 0; k < kend; ++k) {
        const bf16* kr = proj + (rb + k) * PP + 512 + h * 64;
        const bf16* vr = proj + (rb + k) * PP + 1024 + h * 64;
        float s = 0.f;
#pragma unroll
        for (int d = 0; d < 64; ++d) s = fmaf(q[d], bf2f(kr[d]), s);
        s -= cc[k];
        if (k <= qp) {
            const float mn = fmaxf(m, s);
            const float corr = exp2f(m - mn), p = exp2f(s - mn);
            l = l * corr + p;
#pragma unroll
            for (int d = 0; d < 64; ++d) acc[d] = fmaf(acc[d], corr, p * bf2f(vr[d]));
            m = mn;
        }
    }
    const float il = 1.0f / l;
    bf16* o = mix + (rb + qp) * DM + h * 64;
#pragma unroll
    for (int d = 0; d < 64; ++d) o[d] = (bf16)f2bf(acc[d] * il);
}
__global__ __launch_bounds__(256) void diff_k(const bf16* __restrict__ proj, const float* __restrict__ table, float* __restrict__ dtmp) {
    __shared__ float lut[129];
    const int h = blockIdx.y, b = blockIdx.z, q0 = blockIdx.x * 64;
    if (threadIdx.x < 128) lut[threadIdx.x] = table[kBucket[threadIdx.x] * 16 + h] * LOG2E_F;
    if (threadIdx.x == 128) lut[128] = table[31 * 16 + h] * LOG2E_F;
    __syncthreads();
    const size_t rb = (size_t)b * SEQ;
    const int w = threadIdx.x >> 6, lane = threadIdx.x & 63, m_ = w >> 1, vh = w & 1, qp = q0 + lane;
    float q[64], acc[64];
    const bf16* qr = proj + (rb + qp) * PP + 1536 + h * 128 + m_ * 64;
#pragma unroll
    for (int d = 0; d < 64; ++d) { q[d] = bf2f(qr[d]); acc[d] = 0.f; }
    float m = -1e30f, l = 0.f;
    const int kend = q0 + 64;
    for (int k = 0; k < kend; ++k) {
        const bf16* kr = proj + (rb + k) * PP + 2048 + h * 128 + m_ * 64;
        const bf16* vr = proj + (rb + k) * PP + 2560 + h * 128 + vh * 64;
        float s = 0.f;
#pragma unroll
        for (int d = 0; d < 64; ++d) s = fmaf(q[d], bf2f(kr[d]), s);
        if (k <= qp) {
            const int dl = qp - k;
            s += lut[dl < 128 ? dl : 128];
            const float mn = fmaxf(m, s);
            const float corr = exp2f(m - mn), p = exp2f(s - mn);
            l = l * corr + p;
#pragma unroll
            for (int d = 0; d < 64; ++d) acc[d] = fmaf(acc[d], corr, p * bf2f(vr[d]));
            m = mn;
        }
    }
    const float il = 1.0f / l;
    float* o = dtmp + (size_t)m_ * M * 512 + (rb + qp) * 512 + h * 128 + vh * 64;
#pragma unroll
    for (int d = 0; d < 64; ++d) o[d] = acc[d] * il;
}
__global__ __launch_bounds__(256) void diff_combine_k(const float* __restrict__ dtmp, const float* __restrict__ lq1, const float* __restrict__ lk1, const float* __restrict__ lq2,
                                                      const float* __restrict__ lk2, const float* __restrict__ subln, bf16* __restrict__ mix, float lambda_init) {
    const int t = blockIdx.x * blockDim.x + threadIdx.x;
    if (t >= M * 4) return;
    const int row = t >> 2, h = t & 3;
    float s1 = 0.f, s2 = 0.f;
    for (int i = 0; i < 64; ++i) { s1 += lq1[i] * lk1[i]; s2 += lq2[i] * lk2[i]; }
    const float lam = expf(s1) - expf(s2) + lambda_init;
    const float* o0 = dtmp + (size_t)row * 512 + h * 128;
    const float* o1 = dtmp + (size_t)M * 512 + (size_t)row * 512 + h * 128;
    float ss = 0.f;
    for (int e = 0; e < 128; ++e) { const float d = o0[e] - lam * o1[e]; ss += d * d; }
    const float r = rsqrtf(ss * (1.0f / 128.0f) + 1e-6f);
    bf16* o = mix + (size_t)row * DM + 512 + h * 128;
    for (int e = 0; e < 128; ++e) { const float d = o0[e] - lam * o1[e]; o[e] = (bf16)f2bf(d * r * subln[e] * (1.0f - lambda_init)); }
}
__global__ __launch_bounds__(128) void swa_k(const bf16* __restrict__ qkv, const float* __restrict__ table, const float* __restrict__ sinks, bf16* __restrict__ mix) {
    __shared__ float lut[128];
    const int h = blockIdx.y, kvh = h >> 2, b = blockIdx.z, q0 = blockIdx.x * 128, qp = q0 + threadIdx.x;
    lut[threadIdx.x] = table[kBucket[threadIdx.x] * 16 + h] * LOG2E_F;
    __syncthreads();
    const size_t rb = (size_t)b * SEQ;
    float q[64], acc[64];
    const bf16* qr = qkv + (rb + qp) * N_QKV + h * 64;
#pragma unroll
    for (int d = 0; d < 64; ++d) { q[d] = bf2f(qr[d]); acc[d] = 0.f; }
    float m = sinks[h] * LOG2E_F, l = 1.0f;
    int kbeg = q0 - 127; if (kbeg < 0) kbeg = 0;
    const int kend = q0 + 128;
    for (int k = kbeg; k < kend; ++k) {
        const bf16* kr = qkv + (rb + k) * N_QKV + 1024 + kvh * 64;
        const bf16* vr = qkv + (rb + k) * N_QKV + 1280 + kvh * 64;
        float s = 0.f;
#pragma unroll
        for (int d = 0; d < 64; ++d) s = fmaf(q[d], bf2f(kr[d]), s);
        const int dl = qp - k;
        if (dl >= 0 && dl < 128) {
            s += lut[dl];
            const float mn = fmaxf(m, s);
            const float corr = exp2f(m - mn), p = exp2f(s - mn);
            l = l * corr + p;
#pragma unroll
            for (int d = 0; d < 64; ++d) acc[d] = fmaf(acc[d], corr, p * bf2f(vr[d]));
            m = mn;
        }
    }
    const float il = 1.0f / l;
    bf16* o = mix + (rb + qp) * DM + h * 64;
#pragma unroll
    for (int d = 0; d < 64; ++d) o[d] = (bf16)f2bf(acc[d] * il);
}
}
#endif

extern "C" void kernel_launch(void* const* d_in, const int* in_sizes, int n_in, void* d_out, int out_size, void* d_ws, size_t ws_size, hipStream_t stream) {
    static int grid = 0;
    if (grid == 0) {
        if (n_in != 25 || in_sizes[0] != M * DM || out_size != M * DM || ws_size < WS_END) { fprintf(stderr, "kernel_launch: unexpected shapes / workspace (%d inputs, ws %zu)\n", n_in, ws_size); grid = -1; return; }
        int dev = 0, cus = 0, per_cu = 0;
        if (hipGetDevice(&dev) != hipSuccess || hipDeviceGetAttribute(&cus, hipDeviceAttributeMultiprocessorCount, dev) != hipSuccess) { grid = -1; return; }
        if (hipFuncSetAttribute((const void*)skel_fwd, hipFuncAttributeMaxDynamicSharedMemorySize, LDS_BYTES) != hipSuccess) { grid = -1; return; }
        if (hipOccupancyMaxActiveBlocksPerMultiprocessor(&per_cu, (const void*)skel_fwd, NWAVES * 64, LDS_BYTES) != hipSuccess || per_cu < 1) { fprintf(stderr, "kernel_launch: occupancy query says %d workgroups per CU; nothing launched\n", per_cu); grid = -1; return; }
        (void)hipGetLastError();
        grid = cus;
    }
    if (grid < 0) return;
    (void)hipMemsetAsync((char*)d_ws + WS_CTL, 0, CTL_ZERO_BYTES, stream);
    Args a{};
    for (int i = 0; i < 25; ++i) a.in[i] = (const float*)d_in[i];
    a.out = (float*)d_out; a.ws = (unsigned char*)d_ws;
    a.rep_mask = REP_MASK;
    unsigned char* ws = (unsigned char*)d_ws;
    const float* const* in = a.in;
#if MK_MODE == 0
    a.use_bar = 0;
    auto run = [&](int lo, int hi) { a.ph_lo = lo; a.ph_hi = hi; hipLaunchKernelGGL(skel_fwd, dim3(grid), dim3(NWAVES * 64), LDS_BYTES, stream, a); };
    run(0, 1); run(1, 2);
    hipLaunchKernelGGL(simple::fox_k, dim3(SEQ / 128, 8, NB), dim3(128), 0, stream, (const bf16*)(ws + WS_BIG), (const float*)(ws + WS_C2), (bf16*)(ws + WS_MIX));
    hipLaunchKernelGGL(simple::diff_k, dim3(SEQ / 64, 4, NB), dim3(256), 0, stream, (const bf16*)(ws + WS_BIG), in[1], (float*)(ws + WS_R1));
    hipLaunchKernelGGL(simple::diff_combine_k, dim3(M * 4 / 256), dim3(256), 0, stream, (const float*)(ws + WS_R1), in[9], in[10], in[11], in[12], in[13], (bf16*)(ws + WS_MIX), 0.2f);
    run(3, 4); run(4, 5); run(5, 6); run(6, 7);
    hipLaunchKernelGGL(simple::swa_k, dim3(SEQ / 128, 16, NB), dim3(128), 0, stream, (const bf16*)(ws + WS_BIG), in[1], in[19], (bf16*)(ws + WS_MIX));
    run(8, 9); run(9, 10); run(10, 11);
#elif MK_MODE == 1
    a.use_bar = 0;
    for (int p = 0; p < 11; ++p) { a.ph_lo = p; a.ph_hi = p + 1; hipLaunchKernelGGL(skel_fwd, dim3(grid), dim3(NWAVES * 64), LDS_BYTES, stream, a); }
#else
    a.use_bar = 1; a.ph_lo = 0; a.ph_hi = 11;
    hipLaunchKernelGGL(skel_fwd, dim3(grid), dim3(NWAVES * 64), LDS_BYTES, stream, a);
#endif
}
```

```cpp
#include <hip/hip_runtime.h>
#include <cstdio>
#include <cstdint>
#include <cmath>
#define MK_MODE 2
#define REP_MASK 0
namespace pg8 {
#define PG8_LAS __attribute__((address_space(3)))
typedef unsigned short bf16_t;
typedef short bf16x8 __attribute__((ext_vector_type(8)));
typedef float f32x4 __attribute__((ext_vector_type(4)));
typedef unsigned u32x4 __attribute__((ext_vector_type(4)));
constexpr int BM = 256, BK = 64, HALF = 128, HTB = HALF * BK * 2  , STAGE_BYTES = 8 * HTB, NXCD = 8, WGM = 8;

__host__ __device__ __forceinline__ int lds_byte(int r, int c) { const int st = (r >> 4) * 2 + (c >> 5), rr = r & 15, cc = c & 31, ob = rr * 64 + cc * 2; return st * 1024 + (ob ^ (((ob >> 9) & 1) << 5)); }
__host__ __device__ __forceinline__ void stage_rc(int b, int& R, int& C) { const int st = b / 1024, sb = b % 1024, swz = sb ^ (((sb >> 9) & 1) << 5); R = (st >> 1) * 16 + swz / 64; C = (st & 1) * 32 + (swz % 64) / 2; }
__host__ __device__ __forceinline__ int perm32(int rho) { const int n = rho >> 4, i = rho & 15; return 8 * (i >> 2) + 4 * n + (i & 3); }

struct Unit { int pm, pn; };
struct Gemm { const bf16_t* A; const bf16_t* Bt; int M, N, K; };

struct StaticOrder {
    int nM, nN, nwg, G, c, wgm;
    __host__ __device__ void init(int M, int N, int G_, int c_, int wgm_ = WGM) { nM = M / BM; nN = N / BM; nwg = nM * nN; G = G_; c = c_; wgm = wgm_; }
    __host__ __device__ bool next(int i, Unit& u) const {
        const long L = (long)i * G + c; if (L >= nwg) return false;
        int wgid = (int)L; { const int q = nwg / NXCD, r = nwg % NXCD, xcd = wgid % NXCD, off = wgid / NXCD; wgid = (xcd < r ? xcd * (q + 1) : r * (q + 1) + (xcd - r) * q) + off; }
        const int nig = wgm * nN, gid = wgid / nig, fm = gid * wgm, gsz = (nM - fm) < wgm ? (nM - fm) : wgm;
        u.pm = fm + ((wgid % nig) % gsz); u.pn = (wgid % nig) / gsz; return true;
    }
    __device__ __forceinline__ void a_ready(const Unit&) const {}
    __device__ __forceinline__ void done(const Unit&) const {}
};

__device__ __forceinline__ unsigned cvt_pk_bf16(float lo, float hi) { unsigned r; asm volatile("v_cvt_pk_bf16_f32 %0, %1, %2" : "=v"(r) : "v"(lo), "v"(hi)); return r; }
typedef float f32x2 __attribute__((ext_vector_type(2)));

constexpr float RMS_EPS = 1e-6f;
constexpr float LOG2E = 1.4426950408889634f;
constexpr float QSCALE = 0.125f * LOG2E;
__device__ __forceinline__ float row_ss(const float* ssq, int row) { const f32x4 p = *(const f32x4*)(ssq + (size_t)row * 4); return (p[0] + p[1]) + (p[2] + p[3]); }

constexpr int PF_SSQ_OFF = 131072, PF_GT_OFF = 135168;
__device__ __forceinline__ void pf_issue(const float* ssq, const float* gt, const Unit& u, PG8_LAS unsigned char* lds, int wid, int lane) {
    if (gt != nullptr && wid >= 4) __builtin_amdgcn_global_load_lds((const unsigned*)(gt + (lane & 15) * 4), (PG8_LAS unsigned*)(lds + PF_GT_OFF), 16, 0, 0);
    else __builtin_amdgcn_global_load_lds((const unsigned*)(ssq + ((size_t)(u.pm * BM + (wid & 3) * 64 + lane)) * 4), (PG8_LAS unsigned*)(lds + PF_SSQ_OFF + (wid & 3) * 1024), 16, 0, 0);
}
__device__ __forceinline__ float row_ss_lds(PG8_LAS const unsigned char* lds, int lrow) { const f32x4 p = *(PG8_LAS const f32x4*)(lds + PF_SSQ_OFF + lrow * 16); return (p[0] + p[1]) + (p[2] + p[3]); }

template <int LAYER> struct EpiQKV {
    static constexpr bool PERM = true, AFTER_DRAIN = false, PF = true;
    bf16_t* O; int ldc; const float* ssq; const float* gtab; PG8_LAS unsigned char* lds;
    __device__ __forceinline__ void prefetch(const Unit& u, int wid, int lane) const { pf_issue(ssq, gtab + u.pn * 64, u, lds, wid, lane); }
    __device__ __forceinline__ void operator()(const f32x4 (&acc)[2][2][4][2], const Unit& u, int wr, int wc, int fr, int fq) const {
        int kind;
        if (LAYER == 0) kind = (u.pn >> 1) % 3; else kind = u.pn < 4 ? 0 : u.pn - 3;
        const int row0 = u.pm * BM + wr * 64 + fr;
        const int col0 = u.pn * BM + wc * 64 + 8 * fq;
        f32x4 gv[2][2];
#pragma unroll
        for (int bj = 0; bj < 2; ++bj)
#pragma unroll
            for (int n = 0; n < 2; ++n) {
                gv[bj][n] = *(PG8_LAS const f32x4*)(lds + PF_GT_OFF + (32 * bj + 8 * fq + 4 * n) * 4);
            }
        float rsv[8];
#pragma unroll
        for (int q = 0; q < 8; ++q) rsv[q] = row_ss_lds(lds, wr * 64 + fr + (q >> 2) * HALF + (q & 3) * 16);
#pragma unroll
        for (int q = 0; q < 8; ++q) rsv[q] = __builtin_amdgcn_rsqf(rsv[q] * (1.0f / 1024.0f) + RMS_EPS);
#pragma unroll
        for (int ai = 0; ai < 2; ++ai)
#pragma unroll
            for (int m = 0; m < 4; ++m) {
                const int row = row0 + ai * HALF + m * 16;
                const float rs = rsv[ai * 4 + m];
                f32x2 ssv = {0.f, 0.f};
                if (kind < 2) {
#pragma unroll
                    for (int bj = 0; bj < 2; ++bj)
#pragma unroll
                        for (int n = 0; n < 2; ++n) { const f32x4 t = acc[ai][bj][m][n]; const f32x2 t0 = {t[0], t[1]}, t1 = {t[2], t[3]}; ssv = t0 * t0 + ssv; ssv = t1 * t1 + ssv; }
                }
                float sc = rs;
                if (kind < 2) {
                    float ss = (ssv[0] + ssv[1]) * (rs * rs);
                    ss += __shfl_xor(ss, 16); ss += __shfl_xor(ss, 32);
                    sc = rs * __builtin_amdgcn_rsqf(ss * (1.0f / 64.0f) + RMS_EPS);
                }
                const f32x2 scv = {sc, sc};
                f32x4 v[2][2];
#pragma unroll
                for (int bj = 0; bj < 2; ++bj)
#pragma unroll
                    for (int n = 0; n < 2; ++n) {
                        const f32x4 t = acc[ai][bj][m][n], g = gv[bj][n];
                        f32x2 g0 = {g[0], g[1]}, g1 = {g[2], g[3]};
                        if (kind < 2) { g0 = g0 * scv; g1 = g1 * scv; } else { g0 = scv; g1 = scv; }
                        const f32x2 o0 = (f32x2){t[0], t[1]} * g0, o1 = (f32x2){t[2], t[3]} * g1;
                        v[bj][n] = (f32x4){o0[0], o0[1], o1[0], o1[1]};
                    }
                bf16_t* rowp = O + (size_t)row * ldc + col0;
#pragma unroll
                for (int bj = 0; bj < 2; ++bj) {
                    u32x4 w; w.x = cvt_pk_bf16(v[bj][0][0], v[bj][0][1]); w.y = cvt_pk_bf16(v[bj][0][2], v[bj][0][3]); w.z = cvt_pk_bf16(v[bj][1][0], v[bj][1][1]); w.w = cvt_pk_bf16(v[bj][1][2], v[bj][1][3]);
                    *(u32x4*)(rowp + 32 * bj) = w;
                }
            }
    }
};

template <bool FINAL> struct EpiRes {
    static constexpr bool PERM = true, AFTER_DRAIN = false, PF = false;
    const bf16_t* res; bf16_t* outb; float* outf; float* ssq; PG8_LAS float* xs;
    __device__ __forceinline__ void operator()(const f32x4 (&acc)[2][2][4][2], const Unit& u, int wr, int wc, int fr, int fq) const {
        const int row0 = u.pm * BM + wr * 64 + fr, col0 = u.pn * BM + wc * 32 + 8 * fq;
#pragma unroll
        for (int ai = 0; ai < 2; ++ai) {
            u32x4 pre[4][2];
#pragma unroll
            for (int m = 0; m < 4; ++m)
#pragma unroll
                for (int bj = 0; bj < 2; ++bj) pre[m][bj] = *(const u32x4*)(res + ((unsigned)(row0 + ai * HALF + m * 16) * 1024u + (unsigned)(col0 + bj * HALF)));
#pragma unroll
            for (int m = 0; m < 4; ++m) {
                const int row = row0 + ai * HALF + m * 16; const unsigned off = (unsigned)row * 1024u + (unsigned)col0;
                f32x2 ssv = {0.f, 0.f};
#pragma unroll
                for (int bj = 0; bj < 2; ++bj) {
                    const unsigned c = off + (unsigned)(bj * HALF);
                    const u32x4 rv = pre[m][bj];
                    f32x4 o0, o1;
                    o0[0] = __builtin_bit_cast(float, rv.x << 16); o0[1] = __builtin_bit_cast(float, rv.x & 0xffff0000u); o0[2] = __builtin_bit_cast(float, rv.y << 16); o0[3] = __builtin_bit_cast(float, rv.y & 0xffff0000u);
                    o1[0] = __builtin_bit_cast(float, rv.z << 16); o1[1] = __builtin_bit_cast(float, rv.z & 0xffff0000u); o1[2] = __builtin_bit_cast(float, rv.w << 16); o1[3] = __builtin_bit_cast(float, rv.w & 0xffff0000u);
                    o0 = o0 + acc[ai][bj][m][0]; o1 = o1 + acc[ai][bj][m][1];
#if defined(PROBE_STAMP) || defined(PROBE_STEPS) || defined(PROBE_CYC) || defined(PROBE_IMBAL)
                    if (FINAL && c == 0) o0[0] += ssq[0];
#endif
                    if (FINAL) { *(f32x4*)(outf + c) = o0; *(f32x4*)(outf + c + 4) = o1; }
                    else {
                        { const f32x2 a0 = {o0[0], o0[1]}, a1 = {o0[2], o0[3]}, a2 = {o1[0], o1[1]}, a3 = {o1[2], o1[3]}; ssv = a0 * a0 + ssv; ssv = a1 * a1 + ssv; ssv = a2 * a2 + ssv; ssv = a3 * a3 + ssv; }
                        u32x4 w; w.x = cvt_pk_bf16(o0[0], o0[1]); w.y = cvt_pk_bf16(o0[2], o0[3]); w.z = cvt_pk_bf16(o1[0], o1[1]); w.w = cvt_pk_bf16(o1[2], o1[3]);
                        *(u32x4*)(outb + c) = w;
                    }
                }
                if (!FINAL) { float ss = ssv[0] + ssv[1]; ss += __shfl_xor(ss, 16); ss += __shfl_xor(ss, 32); if (fq == 0) xs[(ai * HALF + wr * 64 + m * 16 + fr) * 4 + wc] = ss; }
            }
        }
        if (!FINAL) {
            asm volatile("s_waitcnt lgkmcnt(0)\n\ts_barrier" ::: "memory");
            const int tid = (wr * 4 + wc) * 64 + fq * 16 + fr;
            if (tid < 256) { const f32x4 v = *(const PG8_LAS f32x4*)(xs + tid * 4); ssq[(size_t)(u.pm * BM + tid) * 4 + u.pn] = (v[0] + v[1]) + (v[2] + v[3]); }
        }
    }
};

struct EpiSwiGLU {
    static constexpr bool PERM = true, AFTER_DRAIN = false, PF = true;
    bf16_t* H; int ldh; const float* ssq; PG8_LAS unsigned char* lds;
    __device__ __forceinline__ void prefetch(const Unit& u, int wid, int lane) const { pf_issue(ssq, nullptr, u, lds, wid, lane); }
    __device__ __forceinline__ void operator()(const f32x4 (&acc)[2][2][4][2], const Unit& u, int wr, int wc, int fr, int fq) const {
        const int row0 = u.pm * BM + wr * 64 + fr, hcol = u.pn * HALF + wc * 32 + 8 * fq;
        float rsv[8];
#pragma unroll
        for (int q = 0; q < 8; ++q) rsv[q] = row_ss_lds(lds, wr * 64 + fr + (q >> 2) * HALF + (q & 3) * 16);
#pragma unroll
        for (int q = 0; q < 8; ++q) rsv[q] = __builtin_amdgcn_rsqf(rsv[q] * (1.0f / 1024.0f) + RMS_EPS);
#pragma unroll
        for (int ai = 0; ai < 2; ++ai)
#pragma unroll
            for (int m = 0; m < 4; ++m) {
                const int row = row0 + ai * HALF + m * 16;
                const float rs = rsv[ai * 4 + m];
                const f32x2 c1 = {-rs * LOG2E, -rs * LOG2E}, rs2 = {rs * rs, rs * rs}, one = {1.0f, 1.0f};
                unsigned wv[4];
#pragma unroll
                for (int n = 0; n < 2; ++n)
#pragma unroll
                    for (int p = 0; p < 2; ++p) {
                        const f32x2 av = {acc[ai][0][m][n][2 * p], acc[ai][0][m][n][2 * p + 1]}, bv = {acc[ai][1][m][n][2 * p], acc[ai][1][m][n][2 * p + 1]};
                        const f32x2 t = av * c1;
                        f32x2 e; e[0] = __builtin_amdgcn_exp2f(t[0]); e[1] = __builtin_amdgcn_exp2f(t[1]);
                        const f32x2 d = e + one;
                        f32x2 r; r[0] = __builtin_amdgcn_rcpf(d[0]); r[1] = __builtin_amdgcn_rcpf(d[1]);
                        const f32x2 hv = (av * bv) * (r * rs2);
                        wv[2 * n + p] = cvt_pk_bf16(hv[0], hv[1]);
                    }
                u32x4 w; w.x = wv[0]; w.y = wv[1]; w.z = wv[2]; w.w = wv[3];
                *(u32x4*)(H + (size_t)row * ldh + hcol) = w;
            }
    }
};


struct EpiNull {
    static constexpr bool PERM = true, AFTER_DRAIN = false, PF = false;
    __device__ __forceinline__ void operator()(const f32x4 (&acc)[2][2][4][2], const Unit& u, int wr, int wc, int fr, int fq) const {
#pragma unroll
        for (int ai = 0; ai < 2; ++ai)
#pragma unroll
            for (int bj = 0; bj < 2; ++bj)
#pragma unroll
                for (int m = 0; m < 4; ++m)
#pragma unroll
                    for (int n = 0; n < 2; ++n) asm volatile("" :: "v"(acc[ai][bj][m][n]));
    }
};

template <class Epi, class Sched, bool ALIGN_EPI = false, bool SP2 = false>
__device__ __forceinline__ void gemm_phase(PG8_LAS unsigned char* lds, const Gemm g, const Sched& S, const Epi& E) {
    const int tid = threadIdx.x, wid = __builtin_amdgcn_readfirstlane(tid >> 6), lane = tid & 63, wr = wid >> 2, wc = wid & 3, fr = lane & 15, fq = lane >> 4;
    const int K = g.K, nt = K / BK;
    unsigned voffA[2], voffB[2];
#pragma unroll
    for (int i = 0; i < 2; ++i) { int R, C; stage_rc(tid * 16 + i * 8192, R, C); const int Rb = Epi::PERM ? ((R & ~31) + perm32(R & 31)) : R;
        voffA[i] = (unsigned)(R * K + C) * 2u; voffB[i] = (unsigned)(Rb * K + C) * 2u; }
    const size_t kstep = (size_t)(BK * 2);
    const size_t hstep = (size_t)HALF * K * 2;
    const size_t tstep = 2 * hstep;
    const unsigned ldsw = (unsigned)wid * 1024u;
    const int aoff = lds_byte(wr * 64 + fr, fq * 8), boff = lds_byte(wc * 32 + fr, fq * 8);
#define PG8_SA(b, h) (((b) * 2 + (h)) * HTB)
#define PG8_SB(b, h) ((4 + (b) * 2 + (h)) * HTB)
#define PG8_STAGE(bufoff, gbase, voff) do { _Pragma("unroll") for (int _i = 0; _i < 2; ++_i) \
        __builtin_amdgcn_global_load_lds((const unsigned*)((const char*)(gbase) + (voff)[_i]), (PG8_LAS unsigned*)(lds + (bufoff) + ldsw + _i * 8192), 16, 0, 0); } while (0)
#define PG8_LDA(dst, b, h) do { _Pragma("unroll") for (int m = 0; m < 4; ++m) _Pragma("unroll") for (int k = 0; k < 2; ++k) dst[m][k] = *(const PG8_LAS bf16x8*)(lds + PG8_SA(b, h) + aoff + m * 2048 + k * 1024); } while (0)
#define PG8_LDB(dst, b, h) do { _Pragma("unroll") for (int n = 0; n < 2; ++n) _Pragma("unroll") for (int k = 0; k < 2; ++k) dst[n][k] = *(const PG8_LAS bf16x8*)(lds + PG8_SB(b, h) + boff + n * 2048 + k * 1024); } while (0)
#define PG8_MMA(ai, bj, At, Bt) do { __builtin_amdgcn_s_setprio(1); _Pragma("unroll") for (int m = 0; m < 4; ++m) _Pragma("unroll") for (int n = 0; n < 2; ++n) _Pragma("unroll") for (int k = 0; k < 2; ++k) \
        acc[ai][bj][m][n] = __builtin_amdgcn_mfma_f32_16x16x32_bf16(Bt[n][k], At[m][k], acc[ai][bj][m][n], 0, 0, 0); __builtin_amdgcn_s_setprio(0); } while (0)
#define PG8_WAIT_V(n) asm volatile("s_waitcnt vmcnt(" #n ")" ::: "memory")
#define PG8_WAIT_L(n) asm volatile("s_waitcnt lgkmcnt(" #n ")" ::: "memory")
#define PG8_BAR __builtin_amdgcn_s_barrier()
#define PG8_SCHED __builtin_amdgcn_sched_barrier(0)
    Unit cur, nxt; int ui = 0;
    if (!S.next(0, cur)) return;
    f32x4 acc[2][2][4][2];
#pragma unroll
    for (int a = 0; a < 2; ++a)
#pragma unroll
        for (int b = 0; b < 2; ++b)
#pragma unroll
            for (int m = 0; m < 4; ++m)
#pragma unroll
                for (int n = 0; n < 2; ++n) acc[a][b][m][n] = (f32x4){0.f, 0.f, 0.f, 0.f};
    bf16x8 At[4][2], B0[2][2], B1[2][2];
    const char* cA = (const char*)g.A + (size_t)cur.pm * tstep; const char* cB = (const char*)g.Bt + (size_t)cur.pn * tstep;
    S.a_ready(cur);
    if constexpr (SP2) {
        PG8_STAGE(PG8_SB(0, 0), cB, voffB); PG8_STAGE(PG8_SB(0, 1), cB + hstep, voffB); PG8_STAGE(PG8_SA(0, 0), cA, voffA); PG8_STAGE(PG8_SA(0, 1), cA + hstep, voffA);
        if (wr == 1) PG8_BAR;
        PG8_WAIT_V(2); PG8_BAR;
        PG8_STAGE(PG8_SB(1, 0), cB + kstep, voffB); PG8_STAGE(PG8_SA(1, 0), cA + kstep, voffA); PG8_STAGE(PG8_SB(1, 1), cB + hstep + kstep, voffB);
        PG8_WAIT_V(6); PG8_BAR;
    } else {
        PG8_STAGE(PG8_SB(0, 0), cB, voffB); PG8_STAGE(PG8_SA(0, 0), cA, voffA); PG8_STAGE(PG8_SB(0, 1), cB + hstep, voffB); PG8_STAGE(PG8_SA(0, 1), cA + hstep, voffA);
        if (wr == 1) PG8_BAR;
        PG8_WAIT_V(4); PG8_BAR;
        PG8_STAGE(PG8_SB(1, 0), cB + kstep, voffB); PG8_STAGE(PG8_SA(1, 0), cA + kstep, voffA); PG8_STAGE(PG8_SB(1, 1), cB + hstep + kstep, voffB);
        PG8_WAIT_V(6); PG8_BAR;
    }
    for (;;) {
        const bool has_next = S.next(ui + 1, nxt);
        const char* nA = has_next ? (const char*)g.A + (size_t)nxt.pm * tstep : cA; const char* nB = has_next ? (const char*)g.Bt + (size_t)nxt.pn * tstep : cB;
        for (int t = 0; t < nt; t += 2) {
            const bool last = (t == nt - 2);
            const char* a1 = cA + (size_t)(t + 1) * kstep;
            const char* a2 = last ? nA : cA + (size_t)(t + 2) * kstep; const char* b2 = last ? nB : cB + (size_t)(t + 2) * kstep;
            const char* a3 = a2 + kstep; const char* b3 = b2 + kstep;
            if (last && has_next) S.a_ready(nxt);
            if constexpr (SP2) {
            PG8_LDB(B0, 0, 0); PG8_LDB(B1, 0, 1); PG8_SCHED; PG8_LDA(At, 0, 0); PG8_STAGE(PG8_SA(1, 1), a1 + hstep, voffA);
            bool pf = false; if constexpr (Epi::PF) pf = (t == nt - 4);
            if (pf) { if constexpr (Epi::PF) E.prefetch(cur, wid, lane); PG8_WAIT_V(9); } else { PG8_WAIT_V(8); }
            PG8_WAIT_L(0); PG8_BAR; PG8_MMA(0, 0, At, B0); PG8_MMA(0, 1, At, B1); PG8_BAR; PG8_SCHED;
            PG8_LDA(At, 0, 1); PG8_STAGE(PG8_SB(0, 0), b2, voffB); PG8_STAGE(PG8_SB(0, 1), b2 + hstep, voffB); PG8_STAGE(PG8_SA(0, 0), a2, voffA);
            if (pf) { PG8_WAIT_V(9); } else { PG8_WAIT_V(8); }
            PG8_WAIT_L(0); PG8_BAR; PG8_MMA(1, 0, At, B0); PG8_MMA(1, 1, At, B1); PG8_BAR; PG8_SCHED;
            PG8_LDB(B0, 1, 0); PG8_LDB(B1, 1, 1); PG8_SCHED; PG8_LDA(At, 1, 0); PG8_STAGE(PG8_SA(0, 1), a2 + hstep, voffA);
            PG8_WAIT_V(8); PG8_WAIT_L(0); PG8_BAR; PG8_MMA(0, 0, At, B0); PG8_MMA(0, 1, At, B1); PG8_BAR; PG8_SCHED;
            PG8_LDA(At, 1, 1); PG8_STAGE(PG8_SB(1, 0), b3, voffB); PG8_STAGE(PG8_SB(1, 1), b3 + hstep, voffB); PG8_STAGE(PG8_SA(1, 0), a3, voffA);
            PG8_WAIT_V(8); PG8_WAIT_L(0); PG8_BAR; PG8_MMA(1, 0, At, B0); PG8_MMA(1, 1, At, B1); PG8_BAR; PG8_SCHED;
            } else {
            PG8_LDB(B0, 0, 0); PG8_SCHED; PG8_LDA(At, 0, 0); PG8_STAGE(PG8_SA(1, 1), a1 + hstep, voffA);
            PG8_WAIT_L(8); PG8_BAR; PG8_WAIT_L(0); PG8_MMA(0, 0, At, B0); PG8_BAR; PG8_SCHED;
            PG8_LDB(B1, 0, 1); PG8_STAGE(PG8_SB(0, 0), b2, voffB);
            PG8_BAR; PG8_WAIT_L(0); PG8_MMA(0, 1, At, B1); PG8_BAR;
            PG8_LDA(At, 0, 1); PG8_STAGE(PG8_SA(0, 0), a2, voffA);
            PG8_BAR; PG8_WAIT_L(0); PG8_MMA(1, 0, At, B0); PG8_BAR; PG8_SCHED;
            PG8_STAGE(PG8_SB(0, 1), b2 + hstep, voffB);
            PG8_WAIT_V(6); PG8_BAR; PG8_MMA(1, 1, At, B1); PG8_BAR;
            PG8_LDB(B0, 1, 0); PG8_SCHED; PG8_LDA(At, 1, 0); PG8_STAGE(PG8_SA(0, 1), a2 + hstep, voffA);
            PG8_WAIT_L(8); PG8_BAR; PG8_WAIT_L(0); PG8_MMA(0, 0, At, B0); PG8_BAR; PG8_SCHED;
            PG8_LDB(B1, 1, 1); PG8_STAGE(PG8_SB(1, 0), b3, voffB);
            PG8_BAR; PG8_WAIT_L(0); PG8_MMA(0, 1, At, B1); PG8_BAR;
            PG8_LDA(At, 1, 1); PG8_STAGE(PG8_SA(1, 0), a3, voffA);
            PG8_BAR; PG8_WAIT_L(0); PG8_MMA(1, 0, At, B0); PG8_BAR; PG8_SCHED;
            PG8_STAGE(PG8_SB(1, 1), b3 + hstep, voffB);
            PG8_WAIT_V(6); PG8_BAR; PG8_MMA(1, 1, At, B1); PG8_BAR;
            }
        }
        if constexpr (ALIGN_EPI) { if (wr == 0) PG8_BAR; }
        if constexpr (!Epi::AFTER_DRAIN) { E(acc, cur, wr, wc, fr, fq); S.done(cur); }
        if (!has_next) break;
#pragma unroll
        for (int a = 0; a < 2; ++a)
#pragma unroll
            for (int b = 0; b < 2; ++b)
#pragma unroll
                for (int m = 0; m < 4; ++m)
#pragma unroll
                    for (int n = 0; n < 2; ++n) acc[a][b][m][n] = (f32x4){0.f, 0.f, 0.f, 0.f};
        cur = nxt; cA = nA; cB = nB; ++ui;
        if constexpr (ALIGN_EPI) { if (wr == 1) PG8_BAR; }
    }
    PG8_WAIT_V(0);
    if constexpr (!ALIGN_EPI) { if (wr == 0) PG8_BAR; }
    PG8_BAR;
    if constexpr (Epi::AFTER_DRAIN) { E.fused(acc, cur, wr, wc, fr, fq, lds, wid, lane); S.done(cur); }
#undef PG8_SA
#undef PG8_SB
#undef PG8_STAGE
#undef PG8_LDA
#undef PG8_LDB
#undef PG8_MMA
#undef PG8_WAIT_V
#undef PG8_WAIT_L
#undef PG8_BAR
#undef PG8_SCHED
}
}

#define GAS __attribute__((address_space(1)))
#define LAS __attribute__((address_space(3)))
typedef unsigned short bf16;
typedef unsigned v4u __attribute__((ext_vector_type(4)));
typedef float f32x4 __attribute__((ext_vector_type(4)));
typedef short bf16x8 __attribute__((ext_vector_type(8)));
typedef GAS unsigned gu32;
typedef GAS unsigned long long gu64;
#define RLX_AGENT __ATOMIC_RELAXED, __HIP_MEMORY_SCOPE_AGENT
#define LDS_WAIT() asm volatile("s_waitcnt lgkmcnt(0)" ::: "memory")
#define VM_WAIT() asm volatile("s_waitcnt vmcnt(0)" ::: "memory")
__device__ __forceinline__ unsigned long long rt() { return __builtin_amdgcn_s_memrealtime(); }
__device__ __forceinline__ unsigned f2bf(float f) { unsigned u = __builtin_bit_cast(unsigned, f); return (u + 0x7fffu + ((u >> 16) & 1u)) >> 16; }
__device__ __forceinline__ unsigned pk2(float lo, float hi) { return f2bf(lo) | (f2bf(hi) << 16); }

#define XB_TMO      128
#define XB_XCNT(j)  (256  + 64 * (j))
#define XB_XSUB(j)  (1280 + 64 * (j))
#define XB_XGEN(j)  (2304 + 64 * (j))
#define XB_TOP      3328
#define XB_TOPGEN   3392
#define XCD_BAR_WORDS 3456
#define XB_SPIN_CAP (1u << 18)

__device__ __forceinline__ unsigned xb_ld(unsigned* p)              { return __hip_atomic_load(p, __ATOMIC_RELAXED, __HIP_MEMORY_SCOPE_AGENT); }
__device__ __forceinline__ unsigned xb_add(unsigned* p, unsigned v) { return __hip_atomic_fetch_add(p, v, __ATOMIC_RELAXED, __HIP_MEMORY_SCOPE_AGENT); }
__device__ __forceinline__ unsigned xb_xcc_id() { return (unsigned)__builtin_amdgcn_s_getreg((3 << 11) | 20) & 0xFu; }
#define XB_SPIN(cond, bar) do { unsigned _sp = 0; while (cond) { __builtin_amdgcn_s_sleep(1); \
    if ((++_sp & 255u) == 0u) { if (xb_ld(&(bar)[XB_TMO])) break; if (_sp > XB_SPIN_CAP) { atomicAdd(&(bar)[XB_TMO], 1u); break; } } } } while (0)

struct XcdBarrier {
    unsigned* bar; unsigned x;
    volatile LAS unsigned* st;
};

__device__ __forceinline__ XcdBarrier xcd_barrier_post(unsigned* bar, volatile LAS unsigned* st) {
    XcdBarrier b; b.bar = bar; b.x = xb_xcc_id(); b.st = st;
    if (threadIdx.x == 0) (void)xb_add(&bar[XB_XCNT(b.x)], 1u);
    return b;
}
__device__ __forceinline__ void xcd_barrier_complete(unsigned* bar, unsigned x, unsigned& nloc, unsigned& nx) {
    const unsigned G = gridDim.x * gridDim.y * gridDim.z;
    unsigned sum, cnt, mine, sp = 0u;
    for (;;) {
        sum = 0u; cnt = 0u; mine = 0u;
#pragma unroll
        for (unsigned j = 0; j < 16; ++j) { const unsigned c = xb_ld(&bar[XB_XCNT(j)]); sum += c; cnt += (c > 0u) ? 1u : 0u; mine = (j == x) ? c : mine; }
        if (sum == G) break;
        __builtin_amdgcn_s_sleep(1);
        if ((++sp & 255u) == 0u) { if (xb_ld(&bar[XB_TMO])) break; if (sp > XB_SPIN_CAP) { atomicAdd(&bar[XB_TMO], 1u); break; } }
    }
    nloc = mine > 0u ? mine : 1u; nx = cnt > 0u ? cnt : 1u;
}

__device__ __forceinline__ void xcd_barrier(const XcdBarrier& b) {
    asm volatile("s_waitcnt vmcnt(0)" ::: "memory");
    __syncthreads();
    if (threadIdx.x == 0) {
        unsigned* bar = b.bar;
        __builtin_amdgcn_s_waitcnt(0);
        unsigned nloc = b.st[0], nx = b.st[1];
        if (nloc == 0u) { xcd_barrier_complete(bar, b.x, nloc, nx); b.st[0] = nloc; b.st[1] = nx; }
        const unsigned old = xb_add(&bar[XB_XSUB(b.x)], 1u);
        const unsigned gen = old / nloc;
        if (old + 1u == (gen + 1u) * nloc) {
            __builtin_amdgcn_fence(__ATOMIC_RELEASE, "agent");
            asm volatile("s_waitcnt vmcnt(0)" ::: "memory");
            const unsigned og = xb_add(&bar[XB_TOP], 1u);
            const unsigned tg = og / nx;
            if (og + 1u == (tg + 1u) * nx) xb_add(&bar[XB_TOPGEN], 1u);
            else XB_SPIN(xb_ld(&bar[XB_TOPGEN]) == tg, bar);
            __builtin_amdgcn_fence(__ATOMIC_ACQUIRE, "agent");
            xb_add(&bar[XB_XGEN(b.x)], 1u);
            asm volatile("s_waitcnt vmcnt(0)" ::: "memory");
        } else {
            XB_SPIN(xb_ld(&bar[XB_XGEN(b.x)]) == gen, bar);
            __builtin_amdgcn_fence(__ATOMIC_ACQUIRE, "agent");
            asm volatile("s_waitcnt vmcnt(0)" ::: "memory");
        }
    }
    __syncthreads();
}

constexpr int NWAVES = 8;
constexpr int NB = 16, SEQ = 2048, DM = 1024, M = NB * SEQ;
constexpr int EVW = 3080, N_IN = 3072, FFH = 2816, N_UP = 2 * FFH, N_QKV = 1536;
constexpr float LOG2E_F = 1.4426950408889634f;
constexpr size_t MiB = 1u << 20;
constexpr size_t WS_CTL = 0, CTL_ZERO_BYTES = 1 * MiB;
constexpr size_t WS_SSQ = 186 * MiB;
constexpr size_t WS_GT = 1 * MiB + 768 * 1024;
constexpr size_t WS_LF = 2 * MiB;
constexpr size_t WS_C2 = 3 * MiB;
constexpr size_t WS_W = 4 * MiB;
constexpr size_t WO_IN = 0, WO_EO = WO_IN + (size_t)N_IN * DM * 2, WO_UP0 = WO_EO + (size_t)DM * DM * 2, WO_DN0 = WO_UP0 + (size_t)N_UP * DM * 2,
                 WO_QKV = WO_DN0 + (size_t)DM * FFH * 2, WO_OO = WO_QKV + (size_t)N_QKV * DM * 2, WO_UP1 = WO_OO + (size_t)DM * DM * 2, WO_DN1 = WO_UP1 + (size_t)N_UP * DM * 2,
                 WO_END = WO_DN1 + (size_t)DM * FFH * 2;
static_assert(WO_END <= 46 * MiB, "weights");
constexpr size_t WS_XB = 50 * MiB;
constexpr size_t WS_R1 = 178 * MiB;
constexpr size_t WS_CKREC = 182 * MiB;
constexpr size_t WS_BIG = 306 * MiB;
constexpr size_t WS_MIX = 114 * MiB;
constexpr size_t WS_END = 498 * MiB;
constexpr int CW_BAR = 4096;
constexpr int CW_FOXQ = 24576;

constexpr int RING_OFF = 0, RING_BYTES = 131072;
constexpr int LDSCTL_OFF = 139264, MISC_OFF = LDSCTL_OFF + 320;
constexpr int LDS_BYTES = 147456;

__device__ const unsigned char kBucket[128] = {
    0, 1, 2, 3, 4, 5, 6, 7, 8, 9, 10, 11, 12, 13, 14, 15, 16, 16, 16, 17, 17, 18, 18, 18, 19, 19, 19, 20, 20, 20, 20, 21,
    21, 21, 21, 22, 22, 22, 22, 22, 23, 23, 23, 23, 23, 23, 24, 24, 24, 24, 24, 24, 25, 25, 25, 25, 25, 25, 25, 26, 26, 26, 26, 26,
    26, 26, 26, 27, 27, 27, 27, 27, 27, 27, 27, 27, 27, 28, 28, 28, 28, 28, 28, 28, 28, 28, 28, 29, 29, 29, 29, 29, 29, 29, 29, 29,
    29, 29, 29, 30, 30, 30, 30, 30, 30, 30, 30, 30, 30, 30, 30, 30, 30, 31, 31, 31, 31, 31, 31, 31, 31, 31, 31, 31, 31, 31, 31, 31};

struct Args {
    const float* in[25]; float* out; unsigned char* ws; int ph_lo, ph_hi, use_bar, rep_mask;
};

struct Frame {
    LAS unsigned char* lds;
    volatile LAS unsigned* MISC;
    gu32* ctl;
    int tid, lane, wave, vcu, G;
};

__device__ __forceinline__ float wave_sum(float v) {
#pragma unroll
    for (int o = 1; o < 64; o <<= 1) v += __shfl_xor(v, o);
    return v;
}
__device__ __forceinline__ float bf2f(bf16 v) { return __builtin_bit_cast(float, (unsigned)v << 16); }

enum { MAP_PLAIN = 0, MAP_IN = 1, MAP_HEADPERM = 2, MAP_GATE = 3, MAP_UP = 4 };
__device__ __forceinline__ int dest_row(int kind, int col) {
    if (kind == MAP_PLAIN) return col;
    if (kind == MAP_GATE) return 256 * (col >> 7) + (col & 127);
    if (kind == MAP_UP) return 256 * (col >> 7) + 128 + (col & 127);
    int c = col;
    if (kind == MAP_IN) { if (col >= 1536 && col < 1544) return -1; if (col >= 1544) c = col - 8; }
    const int t = c & ~255, w = c & 255, g = w >> 6, b = (w >> 5) & 1, j = w & 31;
    return t + 128 * b + 32 * g + j;
}
struct WJob { const float* W; const float* gain; bf16* WT; int K, N, kind, start, pad; };
struct TrRegs { f32x4 r[8]; float g[8]; int k0, n0, job; };
constexpr int NJOBS = 10;
__device__ __forceinline__ void tr_load(TrRegs& R, const LAS WJob* jobs, int it, int lane) {
    int jb = 0;
#pragma unroll
    for (int q = 1; q < NJOBS; ++q) if (it >= jobs[q].start) jb = q;
    const LAS WJob& J = jobs[jb];
    const int local = it - J.start, N = J.N, nblk = (N + 31) >> 5, kb = local / nblk, nb = local - kb * nblk;
    R.k0 = 64 * kb; R.n0 = 32 * nb; R.job = jb;
    const float* W = J.W; const float* gain = J.gain;
    const int cc = R.n0 + 4 * (lane & 7);
#pragma unroll
    for (int i = 0; i < 8; ++i) { const int kk = R.k0 + (lane >> 3) + 8 * i;
        R.r[i] = (f32x4){0.f, 0.f, 0.f, 0.f}; if (cc < N) R.r[i] = *(const GAS f32x4*)(W + (size_t)kk * N + cc);
        R.g[i] = 1.0f; if (gain) R.g[i] = gain[kk]; }
}
__device__ __forceinline__ void tr_store(const TrRegs& R, const LAS WJob* jobs, LAS float* scr, int lane) {
    const LAS WJob& J = jobs[R.job];
    const int N = J.N, K = J.K, kind = J.kind; bf16* WT = J.WT;
#pragma unroll
    for (int i = 0; i < 8; ++i) { LAS float* s = scr + ((lane >> 3) + 8 * i) * 33 + 4 * (lane & 7); const float g = R.g[i];
        s[0] = R.r[i].x * g; s[1] = R.r[i].y * g; s[2] = R.r[i].z * g; s[3] = R.r[i].w * g; }
    LDS_WAIT(); asm volatile("" ::: "memory");
    const int c = lane & 7;
#pragma unroll
    for (int j = 0; j < 4; ++j) { const int n = (lane >> 3) + 8 * j; const LAS float* s = scr + (8 * c) * 33 + n;
        v4u o; o.x = pk2(s[0 * 33], s[1 * 33]); o.y = pk2(s[2 * 33], s[3 * 33]); o.z = pk2(s[4 * 33], s[5 * 33]); o.w = pk2(s[6 * 33], s[7 * 33]);
        const int col = R.n0 + n; const int dr = (col < N) ? dest_row(kind, col) : -1;
        if (dr >= 0) *(GAS v4u*)(WT + (size_t)dr * K + R.k0 + 8 * c) = o; }
    LDS_WAIT(); asm volatile("" ::: "memory");
}

struct XRegs { f32x4 v[4]; };
__device__ __forceinline__ void x_load(XRegs& X, const float* x, int m, int lane) {
    const GAS f32x4* xr = (const GAS f32x4*)(x + (size_t)m * DM) + lane;
#pragma unroll
    for (int j = 0; j < 4; ++j) X.v[j] = xr[64 * j];
}
__device__ __forceinline__ void x_row(const XRegs& X, int m, const LAS float* wfT, float* ssq, float* lf, bf16* xb, const float* bfg, int lane) {
    float s = 0.f;
#pragma unroll
    for (int j = 0; j < 4; ++j) s += (X.v[j].x * X.v[j].x + X.v[j].y * X.v[j].y) + (X.v[j].z * X.v[j].z + X.v[j].w * X.v[j].w);
    float ff[8];
#pragma unroll
    for (int h = 0; h < 8; ++h) { float acc = 0.f;
#pragma unroll
        for (int j = 0; j < 4; ++j) { const f32x4 w = *(const LAS f32x4*)(wfT + h * DM + 256 * j + 4 * lane); acc += (X.v[j].x * w.x + X.v[j].y * w.y) + (X.v[j].z * w.z + X.v[j].w * w.w); }
        ff[h] = acc; }
    GAS unsigned long long* o8 = (GAS unsigned long long*)(xb + (size_t)m * DM) + lane;
#pragma unroll
    for (int j = 0; j < 4; ++j) o8[64 * j] = (unsigned long long)pk2(X.v[j].x, X.v[j].y) | ((unsigned long long)pk2(X.v[j].z, X.v[j].w) << 32);
    const bool b5 = lane & 32, b4 = lane & 16, b3 = lane & 8;
    float t4[4];
#pragma unroll
    for (int i = 0; i < 4; ++i) { const float keep = b5 ? ff[i + 4] : ff[i], give = b5 ? ff[i] : ff[i + 4]; t4[i] = keep + __shfl_xor(give, 32); }
    float t2[2];
#pragma unroll
    for (int i = 0; i < 2; ++i) { const float keep = b4 ? t4[i + 2] : t4[i], give = b4 ? t4[i] : t4[i + 2]; t2[i] = keep + __shfl_xor(give, 16); }
    float t1;
    { const float keep = b3 ? t2[1] : t2[0], give = b3 ? t2[0] : t2[1]; t1 = keep + __shfl_xor(give, 8); }
    t1 += __shfl_xor(t1, 4); t1 += __shfl_xor(t1, 2); t1 += __shfl_xor(t1, 1);
    s = wave_sum(s);
    const float rs = __builtin_amdgcn_rsqf(s * (1.0f / DM) + 1e-6f);
    if ((lane & 7) == 0) { const int h = lane >> 3; const float z = t1 * rs + bfg[h]; lf[(size_t)m * 8 + h] = fminf(z, 0.f) - log1pf(expf(-fabsf(z))); }
    if (lane == 1) { *(f32x4*)(ssq + (size_t)m * 4) = (f32x4){s, 0.f, 0.f, 0.f}; }
}

__device__ __forceinline__ void p0_prologue(Frame& F, const Args& a) {
    unsigned char* ws = a.ws;
    bf16* wb = (bf16*)(ws + WS_W);
    LAS float* scr = (LAS float*)(F.lds + RING_OFF + F.wave * 16384);
    LAS WJob* jobs = (LAS WJob*)(F.lds + LDSCTL_OFF + 1024);
    const int gw = F.vcu * NWAVES + F.wave, NGW = F.G * NWAVES;
    int total;
    {
        int st = 0;
#define SETJOB(q, Wp, Kk, Nn, gainp, WTp, kindv) { if (F.tid == 0) { jobs[q].W = (Wp); jobs[q].gain = (gainp); jobs[q].WT = (WTp); jobs[q].K = (Kk); jobs[q].N = (Nn); jobs[q].kind = (kindv); jobs[q].start = st; jobs[q].pad = 0; } \
            st += ((Kk) / 64) * (((Nn) + 31) / 32); }
        SETJOB(0, a.in[3], DM, EVW, a.in[2], (bf16*)((char*)wb + WO_IN), MAP_IN)
        SETJOB(1, a.in[14], DM, DM, (const float*)nullptr, (bf16*)((char*)wb + WO_EO), MAP_PLAIN)
        SETJOB(2, a.in[22], DM, FFH, a.in[21], (bf16*)((char*)wb + WO_UP0), MAP_GATE)
        SETJOB(3, a.in[23], DM, FFH, a.in[21], (bf16*)((char*)wb + WO_UP0), MAP_UP)
        SETJOB(4, a.in[24], FFH, DM, (const float*)nullptr, (bf16*)((char*)wb + WO_DN0), MAP_PLAIN)
        SETJOB(5, a.in[16], DM, N_QKV, a.in[15], (bf16*)((char*)wb + WO_QKV), MAP_HEADPERM)
        SETJOB(6, a.in[20], DM, DM, (const float*)nullptr, (bf16*)((char*)wb + WO_OO), MAP_PLAIN)
        SETJOB(7, a.in[22] + (size_t)DM * FFH, DM, FFH, a.in[21] + DM, (bf16*)((char*)wb + WO_UP1), MAP_GATE)
        SETJOB(8, a.in[23] + (size_t)DM * FFH, DM, FFH, a.in[21] + DM, (bf16*)((char*)wb + WO_UP1), MAP_UP)
        SETJOB(9, a.in[24] + (size_t)FFH * DM, FFH, DM, (const float*)nullptr, (bf16*)((char*)wb + WO_DN1), MAP_PLAIN)
#undef SETJOB
        total = st;
    }
    __syncthreads();
    {
        TrRegs A, B;
        int it = gw;
        if (it < total) tr_load(A, jobs, it, F.lane);
        while (it < total) {
            const int n1 = it + NGW;
            if (n1 < total) tr_load(B, jobs, n1, F.lane);
            tr_store(A, jobs, scr, F.lane);
            if (n1 >= total) break;
            const int n2 = n1 + NGW;
            if (n2 < total) tr_load(A, jobs, n2, F.lane);
            tr_store(B, jobs, scr, F.lane);
            it = n2;
        }
    }
    if (F.vcu == 0) {
        float* gt = (float*)(ws + WS_GT);
        for (int t = F.tid; t < 18 * 64; t += NWAVES * 64) {
            const int tile = t >> 6, e = t & 63; float val;
            if (tile < 12) { const int tt = tile >> 1, kind = tt % 3, grp = tt / 3;
                const float q0 = a.in[5][e], k0 = a.in[6][e], q1 = a.in[7][e], k1 = a.in[8][e];
                const float qv = grp == 0 ? q0 : q1, kv = grp == 0 ? k0 : k1;
                val = kind == 0 ? qv * (0.125f * LOG2E_F) : (kind == 1 ? kv : 1.0f); }
            else { const int pn = tile - 12; const float qv = a.in[17][e], kv = a.in[18][e]; val = pn < 4 ? qv * (0.125f * LOG2E_F) : (pn == 4 ? kv : 1.0f); }
            gt[t] = val;
        }
    }
    __syncthreads();
    LAS float* wfT = (LAS float*)(F.lds + RING_OFF);
    for (int i = F.tid; i < 8 * DM; i += NWAVES * 64) { const int k = i >> 3, h = i & 7; wfT[h * DM + k] = a.in[3][(size_t)k * EVW + 1536 + h] * a.in[2][k]; }
    __syncthreads();
    {
        float* ssq = (float*)(ws + WS_SSQ); float* lf = (float*)(ws + WS_LF); bf16* xb = (bf16*)(ws + WS_XB);
        const float* x = a.in[0]; const float* bfg = a.in[4];
        XRegs A, B;
        int m = gw;
        if (m < M) x_load(A, x, m, F.lane);
        while (m < M) {
            const int m1 = m + NGW;
            if (m1 < M) x_load(B, x, m1, F.lane);
            x_row(A, m, wfT, ssq, lf, xb, bfg, F.lane);
            if (m1 >= M) break;
            const int m2 = m1 + NGW;
            if (m2 < M) x_load(A, x, m2, F.lane);
            x_row(B, m1, wfT, ssq, lf, xb, bfg, F.lane);
            m = m2;
        }
    }
}

__device__ __forceinline__ void cumsum_phase(Frame& F, const Args& a) {
    if (F.vcu >= NB * 8) return;
    const int b = F.vcu >> 3, h = F.vcu & 7;
    const float* lf = (const float*)(a.ws + WS_LF); float* c2 = (float*)(a.ws + WS_C2) + (size_t)F.vcu * SEQ;
    LAS float* wt = (LAS float*)(F.lds + RING_OFF);
    float v[4]; float run = 0.f;
#pragma unroll
    for (int i = 0; i < 4; ++i) { run += lf[((size_t)b * SEQ + 4 * F.tid + i) * 8 + h]; v[i] = run; }
    float inc = run;
#pragma unroll
    for (int o = 1; o < 64; o <<= 1) { const float t = __shfl_up(inc, o); if (F.lane >= o) inc += t; }
    if (F.lane == 63) wt[F.wave] = inc;
    __syncthreads();
    float base = 0.f;
    for (int w = 0; w < F.wave; ++w) base += wt[w];
    const float off = base + inc - run;
    f32x4 o; o.x = (v[0] + off) * LOG2E_F; o.y = (v[1] + off) * LOG2E_F; o.z = (v[2] + off) * LOG2E_F; o.w = (v[3] + off) * LOG2E_F;
    *(f32x4*)(c2 + 4 * F.tid) = o;
    {
        v4u* rec = (v4u*)(a.ws + WS_CKREC) + (size_t)F.vcu * SEQ + 4 * F.tid;
        const float vals[4] = {o.x, o.y, o.z, o.w};
#pragma unroll
        for (int i = 0; i < 4; ++i) { const float nv = -vals[i]; const unsigned hi16 = f2bf(nv); const float hif = __builtin_bit_cast(float, hi16 << 16); const unsigned lo16 = f2bf(nv - hif);
            v4u r; r.x = hi16 | (lo16 << 16); r.y = 0u; r.z = 0u; r.w = 0u; rec[i] = r; }
    }
    __syncthreads();
}

namespace att {
typedef short bf16x8 __attribute__((ext_vector_type(8)));
typedef short s16x4 __attribute__((ext_vector_type(4)));
typedef short v4i16_t __attribute__((ext_vector_type(4)));
typedef float f32x16 __attribute__((ext_vector_type(16)));
typedef float f32x4v __attribute__((ext_vector_type(4)));
typedef unsigned u32x4v __attribute__((ext_vector_type(4)));
typedef int i32x4v __attribute__((ext_vector_type(4)));
typedef __attribute__((address_space(3))) unsigned char* lptr;
typedef __attribute__((address_space(3))) const unsigned char* lcptr;
typedef float f32x2_t __attribute__((ext_vector_type(2))); typedef __bf16 bf16x2_t __attribute__((ext_vector_type(2)));

constexpr int OFF_CK = 98304, OFF_WSF = 101376, OFF_LUT = 141312, OFF_LUT_SWA = 49152, OFF_OST = 106496;
constexpr int LUTN = 320, LUTZ = 94;
constexpr float THR = 16.0f;
constexpr float NEG_INF = -INFINITY;

__device__ __forceinline__ int crow(int r, int hi) { return (r & 3) + 8 * (r >> 2) + 4 * hi; }
__device__ __forceinline__ unsigned cvtpk(float lo, float hi) { f32x2_t v = {lo, hi}; bf16x2_t b = __builtin_convertvector(v, bf16x2_t); return __builtin_bit_cast(unsigned, b); }
__device__ __forceinline__ s16x4 vtr(lcptr p) { return __builtin_bit_cast(s16x4, __builtin_amdgcn_ds_read_tr16_b64_v4i16((__attribute__((address_space(3))) v4i16_t*)p)); }
__device__ __forceinline__ float xhalf_max(float m) { auto rr = __builtin_amdgcn_permlane32_swap(__float_as_uint(m), __float_as_uint(m), false, false); return fmaxf(__uint_as_float(rr[0]), __uint_as_float(rr[1])); }
__device__ __forceinline__ float xhalf_sum(float m) { auto rr = __builtin_amdgcn_permlane32_swap(__float_as_uint(m), __float_as_uint(m), false, false); return __uint_as_float(rr[0]) + __uint_as_float(rr[1]); }

__device__ __forceinline__ void load_q(bf16x8 (&q)[4], const bf16* qp, int pitch, int lane) {
    const int r32 = lane & 31, hi = lane >> 5;
#pragma unroll
    for (int d0 = 0; d0 < 4; ++d0) q[d0] = *(const bf16x8*)(qp + (unsigned)(r32 * pitch + d0 * 16 + hi * 8));
}
struct UnitDesc {
    const bf16* q;
    const bf16* k; const bf16* k2; const bf16* v;
    int pitch;
    const float* c2;
    const float* c2f;
    const bf16* nk; const bf16* nk2; const bf16* nv; const float* nc2;
    int t0, t1;
    int q0;
    unsigned* qctr; int qbase, qlnb, qgb, qug; const bf16* qproj; const char* qck;
};
__device__ __forceinline__ void fox_decode(int idx, int lnb, int gb, int& qb, int& b, int& h) {
    const int per = 16 << lnb, s = idx >> (4 + lnb), r = idx & (per - 1);
    qb = 7 - (r >> (1 + lnb)); b = gb + (r & ((1 << lnb) - 1)); h = 2 * s + ((r >> lnb) & 1);
}

__device__ __forceinline__ float max3f(float a, float b, float c) { float r; asm("v_max3_f32 %0, %1, %2, %3" : "=v"(r) : "v"(a), "v"(b), "v"(c)); return r; }
__device__ __forceinline__ float max2f(float a, float b) { float r; asm("v_max_f32_e32 %0, %1, %2" : "=v"(r) : "v"(a), "v"(b)); return r; }
__device__ __forceinline__ float rowmax32(const f32x16& p0, const f32x16& p1) {
    float a = max3f(p0[0], p0[1], p1[0]), b = max3f(p0[2], p0[3], p1[1]); a = max3f(a, p1[2], p1[3]);
#pragma unroll
    for (int r = 4; r < 16; r += 4) { a = max3f(a, p0[r], p0[r + 1]); b = max3f(b, p0[r + 2], p0[r + 3]); a = max3f(a, p1[r], p1[r + 1]); b = max3f(b, p1[r + 2], p1[r + 3]); }
    return xhalf_max(max2f(a, b));
}
__device__ __forceinline__ void causal_mask(f32x16& p0, f32x16& p1, int mb) {
#pragma unroll
    for (int r = 0; r < 16; ++r) { if ((r & 3) + 8 * (r >> 2) > mb) p0[r] = NEG_INF; if ((r & 3) + 8 * (r >> 2) + 32 > mb) p1[r] = NEG_INF; }
}
__device__ __forceinline__ void lut_bias(f32x16& p0, f32x16& p1, __attribute__((address_space(3))) const float* lutx, int dc0) {
    __attribute__((address_space(3))) const float* pb = lutx + (dc0 + LUTZ - 59);
#pragma unroll
    for (int r = 0; r < 16; ++r) { const int c = (r & 3) + 8 * (r >> 2); p0[r] += pb[59 - c]; p1[r] += pb[59 - c - 32]; }
}

__device__ __forceinline__ void glds16(const void* gsrc, unsigned lds_dst) { unsigned keep;
    asm volatile("s_mov_b32 %0, m0\n\ts_mov_b32 m0, %2\n\ts_nop 0\n\tglobal_load_lds_dwordx4 %1, off\n\ts_mov_b32 m0, %0" : "=&s"(keep) : "v"(gsrc), "s"(lds_dst) : "memory"); }
__device__ __forceinline__ void glds4(const void* gsrc, unsigned lds_dst) { unsigned keep;
    asm volatile("s_mov_b32 %0, m0\n\ts_mov_b32 m0, %2\n\ts_nop 0\n\tglobal_load_lds_dword %1, off\n\ts_mov_b32 m0, %0" : "=&s"(keep) : "v"(gsrc), "s"(lds_dst) : "memory"); }
#define ATT_WAIT_BAR(N) asm volatile("s_waitcnt vmcnt(" #N ") lgkmcnt(0)\n\ts_barrier" ::: "memory")

template <int VAR, int DVB, bool STREAM = false, bool GRP2 = false>
__device__ __forceinline__ void unit_loop_p(LAS unsigned char* lds, const UnitDesc& U, int qw, f32x16 (&o)[DVB], float& mhat, float& l,
                                            __attribute__((address_space(3))) const float* lut, float b31, int kmap, int wave, int lane, unsigned long long (&stamp_acc)[6], unsigned long long& stamp_last, const bf16x8 (&qreg)[4], int stream_dma = -1, bool pre_issued = false, int next_t1 = -1) {
    constexpr int SLOT = (VAR == 1) ? 32768 : 16384, VOFF = (VAR == 1) ? 16384 : 8192;
    const int r32 = lane & 31, hi = lane >> 5;
    const int qpos = qw + r32;
    const lptr qlds = (lptr)lds + OFF_OST + wave * 4096 + lane * 16;
#define P_QF(d0) ((VAR != 1) ? qf[d0] : *(const __attribute__((address_space(3))) bf16x8*)(qlds + (d0) * 1024))
    const unsigned ksrc = (unsigned)(lane * U.pitch + wave * 8), vsrc = (unsigned)((16 * (wave & 3) + (lane >> 2)) * U.pitch + (wave >> 2) * 32 + (lane & 3) * 8);
    const unsigned lds0 = (unsigned)(uintptr_t)lds;
    const unsigned dstw = lds0 + (unsigned)wave * 1024u;
    const int t0 = U.t0, t1 = U.t1;
    int tend = t1;
#define P_TILE2(i, T1) ((VAR == 0) ? ((T1) - (i)) : (i))
#define P_TILE(i) P_TILE2(i, t1)
#define P_INR(i) (P_TILE(i) >= t0w && P_TILE(i) <= t1w)
    int t0w = t0; const int t1w = ((qw + 31) >> 6) < t1 ? ((qw + 31) >> 6) : t1;
    if (VAR == 2) { while (64 * t0w + 63 <= qw - 128) ++t0w; }
    __attribute__((address_space(3))) float* wsf = (__attribute__((address_space(3))) float*)((lptr)lds + OFF_WSF + wave * 256);
    const lcptr kfb = (lcptr)lds + kmap * 8192 + hi * 1024 + r32 * 16;
    const lcptr vfb = (lcptr)lds + VOFF + ((lane >> 4) & 1) * 32 + (lane & 3) * 8 + (4 * hi + ((lane & 15) >> 2)) * 64;
#define P_SLOT(u) ((int)((unsigned)(u) % (STREAM ? 6u : 3u)) * SLOT)
#define P_DMAK3(u, T1, KB, KB2, CB) do { const unsigned to_ = (unsigned)(P_TILE2(u, T1) * 64 * U.pitch) + ksrc; const unsigned sd_ = (unsigned)__builtin_amdgcn_readfirstlane((int)(dstw + (unsigned)P_SLOT(u))); \
        glds16((KB) + to_, sd_); if (VAR == 1) glds16((KB2) + to_, sd_ + 8192u); \
        if (VAR == 0) { if (wave == 0) glds16((const char*)(CB) + (size_t)(P_TILE2(u, T1) * 64 + lane) * 16, (unsigned)__builtin_amdgcn_readfirstlane((int)(lds0 + OFF_CK + ((unsigned)(u) % 3u) * 1024u))); } } while (0)
#define P_DMAK2(u, T1) P_DMAK3(u, T1, U.k, U.k2, U.c2)
#define P_DMAK(u) P_DMAK2(u, t1)
#define P_DMAV3(u, T1, VB) do { const unsigned to_ = (unsigned)(P_TILE2(u, T1) * 64 * U.pitch) + vsrc; const unsigned sd_ = (unsigned)__builtin_amdgcn_readfirstlane((int)(dstw + (unsigned)(P_SLOT(u) + VOFF))); \
        glds16((VB) + to_, sd_); if (VAR == 1) glds16((VB) + to_ + 64, sd_ + 8192u); } while (0)
#define P_DMAV2(u, T1) P_DMAV3(u, T1, U.v)
#define P_DMAV(u) P_DMAV2(u, t1)
#define P_SB() __builtin_amdgcn_sched_barrier(0)
    if (!STREAM) { if (!pre_issued) { P_DMAK(t0); P_DMAV(t0); if (t0 + 1 <= t1) P_DMAK(t0 + 1); } }
#pragma unroll
    for (int d0 = 0; d0 < 4; ++d0) { if (VAR == 1) *(__attribute__((address_space(3))) bf16x8*)(qlds + d0 * 1024) = qreg[d0]; }
    bf16x8 qf[4];
#pragma unroll
    for (int d0 = 0; d0 < 4; ++d0) qf[d0] = qreg[d0];
    if (STREAM) { if (stream_dma >= 0) { P_DMAK(stream_dma); P_DMAV(stream_dma); } }
    int qtok = 0x7fffffff;
    if (!STREAM) {
    ATT_WAIT_BAR(0);
    if (VAR == 0) { if (U.qctr != nullptr && threadIdx.x == 0) qtok = U.qbase + (int)__hip_atomic_fetch_add(U.qctr, 1u, __ATOMIC_RELAXED, __HIP_MEMORY_SCOPE_AGENT); }
    if (t0 + 2 <= t1) P_DMAK(t0 + 2);
    }
    f32x16 negm; bf16x8 q5 = (bf16x8){0, 0, 0, 0, 0, 0, 0, 0}; if (hi == 0) { q5[0] = (short)0x3F80; q5[1] = (short)0x3F80; }
    f32x16 PA0, PA1, PB0, PB1;
    PA0 = f32x16{}; PA1 = f32x16{}; PB0 = f32x16{}; PB1 = f32x16{};

#define P_CINIT(u) do { float ci_ = -mhat; if (VAR == 1) { if (qw - (64 * (u) + 63) >= 128) ci_ += b31; } _Pragma("unroll") for (int r_ = 0; r_ < 16; ++r_) negm[r_] = ci_; } while (0)
#define P_K5A(u) (*(const __attribute__((address_space(3))) bf16x8*)((lcptr)lds + OFF_CK + (int)((unsigned)(u) % 3u) * 1024 + r32 * 16))
#define P_K5B(u) (*(const __attribute__((address_space(3))) bf16x8*)((lcptr)lds + OFF_CK + (int)((unsigned)(u) % 3u) * 1024 + 512 + r32 * 16))
#define P_QK(P0, P1, u) do { lcptr kb_ = kfb + P_SLOT(u); asm volatile("" : "+v"(kb_)); P_CINIT(P_TILE(u)); const f32x16 z_ = negm; \
        _Pragma("unroll") for (int d0_ = 0; d0_ < 4; ++d0_) { \
            const bf16x8 k0_ = *(const __attribute__((address_space(3))) bf16x8*)(kb_ + d0_ * 2048), k1_ = *(const __attribute__((address_space(3))) bf16x8*)(kb_ + d0_ * 2048 + 512); \
            const bf16x8 q_ = P_QF(d0_); P0 = __builtin_amdgcn_mfma_f32_32x32x16_bf16(k0_, q_, d0_ == 0 ? z_ : P0, 0, 0, 0); P1 = __builtin_amdgcn_mfma_f32_32x32x16_bf16(k1_, q_, d0_ == 0 ? z_ : P1, 0, 0, 0); } \
        if (VAR == 0) { P0 = __builtin_amdgcn_mfma_f32_32x32x16_bf16(P_K5A(u), q5, P0, 0, 0, 0); P1 = __builtin_amdgcn_mfma_f32_32x32x16_bf16(P_K5B(u), q5, P1, 0, 0, 0); } } while (0)
#define P_SM1(P0, P1, u, isfirst) do { \
        asm volatile("s_nop 15\n\ts_nop 7" : "+v"(P0), "+v"(P1));        \
        if (VAR == 0) { if (64 * P_TILE(u) + 63 > qw) causal_mask(P0, P1, qpos - 64 * P_TILE(u) - 4 * hi); } \
        else { if ((VAR == 2) || (qw - (64 * (u) + 63) < 128)) lut_bias(P0, P1, lut, qpos - 64 * (u) - 4 * hi); } \
        const float rm_ = rowmax32(P0, P1); \
        if ((isfirst) || __any(rm_ > THR)) { float dl_ = (isfirst) ? rm_ : fmaxf(rm_, 0.f); if (dl_ == NEG_INF) dl_ = 0.f; mhat += dl_; fres_ = __builtin_amdgcn_exp2f(-dl_); resc_ = true; \
            _Pragma("unroll") for (int r_ = 0; r_ < 16; ++r_) { P0[r_] -= dl_; P1[r_] -= dl_; } } } while (0)
    {
        bool resc_ = false; float fres_ = 1.f;
        if (P_INR(t0)) {
            P_QK(PA0, PA1, t0);
            P_SM1(PA0, PA1, t0, VAR != 2);
#pragma unroll
            for (int r = 0; r < 16; ++r) { PA0[r] = __builtin_amdgcn_exp2f(PA0[r]); PA1[r] = __builtin_amdgcn_exp2f(PA1[r]); }
            if (VAR == 2 && resc_) { l *= fres_; }
        }
    }
    if (!STREAM) asm volatile("s_waitcnt lgkmcnt(0)\n\ts_barrier" ::: "memory");
#define P_GAPA(PC0, PC1, i) do { if ((i) < 4) { sacc_ += (PC0[4 * (i)] + PC0[4 * (i) + 1]) + (PC0[4 * (i) + 2] + PC0[4 * (i) + 3]); pw_[(i) >> 1][2 * ((i) & 1)] = cvtpk(PC0[4 * (i)], PC0[4 * (i) + 1]); pw_[(i) >> 1][2 * ((i) & 1) + 1] = cvtpk(PC0[4 * (i) + 2], PC0[4 * (i) + 3]); } \
        else { sacc_ += (PC1[4 * ((i) - 4)] + PC1[4 * ((i) - 4) + 1]) + (PC1[4 * ((i) - 4) + 2] + PC1[4 * ((i) - 4) + 3]); pw_[(i) >> 1][2 * ((i) & 1)] = cvtpk(PC1[4 * ((i) - 4)], PC1[4 * ((i) - 4) + 1]); pw_[(i) >> 1][2 * ((i) & 1) + 1] = cvtpk(PC1[4 * ((i) - 4) + 2], PC1[4 * ((i) - 4) + 3]); } } while (0)
#define P_EXP4(PN0, PN1, j) do { if ((j) < 4) { _Pragma("unroll") for (int e_ = 0; e_ < 4; ++e_) PN0[4 * (j) + e_] = __builtin_amdgcn_exp2f(PN0[4 * (j) + e_]); } \
        else { _Pragma("unroll") for (int e_ = 0; e_ < 4; ++e_) PN1[4 * ((j) - 4) + e_] = __builtin_amdgcn_exp2f(PN1[4 * ((j) - 4) + e_]); } } while (0)
#if defined(PROBE_ADD_MFMA)
#define PROBE_MFMA8(a_, b_, c_, d_, qa, qb) do { f32x16 dm_ = f32x16{}; dm_ = __builtin_amdgcn_mfma_f32_32x32x16_bf16(a_, qa, dm_, 0, 0, 0); dm_ = __builtin_amdgcn_mfma_f32_32x32x16_bf16(b_, qa, dm_, 0, 0, 0); \
        dm_ = __builtin_amdgcn_mfma_f32_32x32x16_bf16(c_, qb, dm_, 0, 0, 0); dm_ = __builtin_amdgcn_mfma_f32_32x32x16_bf16(d_, qb, dm_, 0, 0, 0); dm_ = __builtin_amdgcn_mfma_f32_32x32x16_bf16(a_, qb, dm_, 0, 0, 0); \
        dm_ = __builtin_amdgcn_mfma_f32_32x32x16_bf16(b_, qb, dm_, 0, 0, 0); dm_ = __builtin_amdgcn_mfma_f32_32x32x16_bf16(c_, qa, dm_, 0, 0, 0); dm_ = __builtin_amdgcn_mfma_f32_32x32x16_bf16(d_, qa, dm_, 0, 0, 0); asm volatile("" :: "v"(dm_)); } while (0)
#else
#define PROBE_MFMA8(a_, b_, c_, d_, qa, qb) do {} while (0)
#endif
#if defined(PROBE_ADD_EXP)
#define PROBE_EXP4(PN0, PN1, j) do { _Pragma("unroll") for (int e_ = 0; e_ < 4; ++e_) { float x_ = ((j) < 4 ? PN0[4 * ((j) & 3) + e_] : PN1[4 * ((j) & 3) + e_]); asm volatile("" : "+v"(x_)); x_ = __builtin_amdgcn_exp2f(x_); asm volatile("" :: "v"(x_)); } } while (0)
#else
#define PROBE_EXP4(PN0, PN1, j) do {} while (0)
#endif
#if defined(PROBE_ADD_BAR)
#define PROBE_BAR() asm volatile("s_waitcnt lgkmcnt(0)\n\ts_barrier" ::: "memory")
#else
#define PROBE_BAR() do {} while (0)
#endif
#if defined(PROBE_STAMP)
#define P_STAMP(k) do { __builtin_amdgcn_sched_barrier(0); unsigned long long ts_; asm volatile("s_memtime %0\n\ts_waitcnt lgkmcnt(0)" : "=s"(ts_) :: "memory"); __builtin_amdgcn_sched_barrier(0); stamp_acc[k] += ts_ - stamp_last; stamp_last = ts_; } while (0)
#else
#define P_STAMP(k) do {} while (0)
#endif
    __attribute__((address_space(3))) int* pflags = (__attribute__((address_space(3))) int*)((lptr)lds + OFF_WSF + 2048);
#define P_PRUNE_VOTE(t) do { if (VAR == 0) { int ok_ = 1; const int i2_ = (t) + 2; \
            if (i2_ <= t1) {   \
                const unsigned w_ = *(const __attribute__((address_space(3))) unsigned*)((lcptr)lds + OFF_CK + (int)((unsigned)((t) + 1) % 3u) * 1024); \
                const float nb_ = __builtin_bit_cast(float, w_ << 16) + __builtin_bit_cast(float, w_ & 0xffff0000u); \
                const bool st_ = (P_TILE((t) + 1) <= t1w); ok_ = (st_ && __all(mhat - b31 - nb_ > 31.0f)) ? 1 : 0; } \
            if (lane == 0) pflags[((t) & 1) * 8 + wave] = ok_; } } while (0)
#define P_PRUNE_READ(t) do { if (VAR == 0) { const i32x4v fa_ = *(const __attribute__((address_space(3))) i32x4v*)(pflags + ((t) & 1) * 8), fb_ = *(const __attribute__((address_space(3))) i32x4v*)(pflags + ((t) & 1) * 8 + 4); \
            const int all_ = fa_[0] & fa_[1] & fa_[2] & fa_[3] & fb_[0] & fb_[1] & fb_[2] & fb_[3]; \
            if (__builtin_amdgcn_readfirstlane(all_) && (t) + 1 < tend) tend = (t) + 1; } } while (0)
#if defined(PROBE_CYC)
#define P_CNT() do { stamp_acc[0] += 1; unsigned long long ts_; asm volatile("s_memtime %0\n\ts_waitcnt lgkmcnt(0)" : "=s"(ts_) :: "memory"); if (stamp_last) stamp_acc[2] += ts_ - stamp_last; stamp_last = ts_; } while (0)
#elif defined(PROBE_STEPS)
#define P_CNT() do { stamp_acc[0] += 1; } while (0)
#else
#define P_CNT() do {} while (0)
#endif
#define P_PHASEB(PW, TV, PX0, PX1, DOEXP) do { \
        lcptr vb_ = vfb + P_SLOT(TV); asm volatile("" : "+v"(vb_)); \
        s16x4 vl_[4], vh_[4]; \
        _Pragma("unroll") for (int q_ = 0; q_ < 4; ++q_) { vl_[q_] = vtr(vb_ + q_ * 1024); vh_[q_] = vtr(vb_ + q_ * 1024 + 512); } \
        P_SB(); \
        _Pragma("unroll") for (int j_ = 0; j_ < DVB * 4; ++j_) { \
            const int d_ = j_ >> 2, ks_ = j_ & 3; \
            const bf16x8 vf_ = (bf16x8){vl_[ks_][0], vl_[ks_][1], vl_[ks_][2], vl_[ks_][3], vh_[ks_][0], vh_[ks_][1], vh_[ks_][2], vh_[ks_][3]}; \
            o[d_] = __builtin_amdgcn_mfma_f32_32x32x16_bf16(__builtin_bit_cast(bf16x8, PW[ks_]), vf_, o[d_], 0, 0, 0); \
            if (j_ + 4 < DVB * 4) { const int dn_ = (j_ + 4) >> 2, dof_ = (dn_ >> 1) * 8192 + (dn_ & 1) * 4096 + ks_ * 1024; vl_[ks_] = vtr(vb_ + dof_); vh_[ks_] = vtr(vb_ + dof_ + 512); } \
            if (DOEXP) { if (DVB == 2) { P_EXP4(PX0, PX1, j_); } else { if ((j_ & 1) == 0) { P_EXP4(PX0, PX1, j_ >> 1); } } } \
            P_SB(); } \
        asm volatile("" : "+v"(PX0), "+v"(PX1));        \
    } while (0)
#define P_RESCALE(F_) do { l *= (F_); if (hi == 0) wsf[r32] = (F_); asm volatile("s_waitcnt lgkmcnt(0)" ::: "memory"); \
        _Pragma("unroll") for (int r_ = 0; r_ < 16; ++r_) { const float fr_ = wsf[crow(r_, hi)]; _Pragma("unroll") for (int d_ = 0; d_ < DVB; ++d_) o[d_][r_] *= fr_; } } while (0)
#define P_STEP_BAR(t) do { if (!STREAM) { if (fullq_) { if (VAR == 0) { if (wave == 0) { ATT_WAIT_BAR(2); } else { ATT_WAIT_BAR(1); } } else if (VAR == 1) { ATT_WAIT_BAR(2); } else { ATT_WAIT_BAR(1); } } else { ATT_WAIT_BAR(0); } } \
        P_PRUNE_READ(t); } while (0)
#define P_STEP(PC0, PC1, PN0, PN1, t) do { \
        P_CNT(); \
        const bool curv_ = P_INR(t), nxtv_ = ((t) + 1 <= tend) && P_INR((t) + 1); \
        const bool fullq_ = ((t) + 3 <= t1); \
          \
        if (!curv_) { asm volatile("; tile not needed by this wave: zero probabilities" ::: "memory"); PC0 = f32x16{}; PC1 = f32x16{}; }     \
        if (!STREAM) { if ((t) + 1 <= t1) P_DMAV((t) + 1); }        \
        float sacc_ = 0.f; u32x4v pw_[4]; bool resc_ = false; float fres_ = 1.f; \
        { \
            lcptr kb_ = kfb + P_SLOT((t) + 1); asm volatile("" : "+v"(kb_)); P_CINIT(P_TILE((t) + 1)); const f32x16 z_ = negm; \
            bf16x8 ka_ = *(const __attribute__((address_space(3))) bf16x8*)(kb_), kb2_ = *(const __attribute__((address_space(3))) bf16x8*)(kb_ + 512); \
            bf16x8 kc_ = *(const __attribute__((address_space(3))) bf16x8*)(kb_ + 2048), kd_ = *(const __attribute__((address_space(3))) bf16x8*)(kb_ + 2048 + 512); \
            bf16x8 qa_ = P_QF(0), qb_ = P_QF(1); \
            P_SB(); \
            PN0 = __builtin_amdgcn_mfma_f32_32x32x16_bf16(ka_, qa_, z_, 0, 0, 0); ka_ = *(const __attribute__((address_space(3))) bf16x8*)(kb_ + 4096); P_GAPA(PC0, PC1, 0); P_SB(); \
            PN1 = __builtin_amdgcn_mfma_f32_32x32x16_bf16(kb2_, qa_, z_, 0, 0, 0); qa_ = P_QF(2); kb2_ = *(const __attribute__((address_space(3))) bf16x8*)(kb_ + 4096 + 512); P_GAPA(PC0, PC1, 1); P_SB(); \
            PN0 = __builtin_amdgcn_mfma_f32_32x32x16_bf16(kc_, qb_, PN0, 0, 0, 0); kc_ = *(const __attribute__((address_space(3))) bf16x8*)(kb_ + 6144); P_GAPA(PC0, PC1, 2); P_SB(); \
            PN1 = __builtin_amdgcn_mfma_f32_32x32x16_bf16(kd_, qb_, PN1, 0, 0, 0); qb_ = P_QF(3); kd_ = *(const __attribute__((address_space(3))) bf16x8*)(kb_ + 6144 + 512); P_GAPA(PC0, PC1, 3); P_SB(); \
            PN0 = __builtin_amdgcn_mfma_f32_32x32x16_bf16(ka_, qa_, PN0, 0, 0, 0); P_GAPA(PC0, PC1, 4); P_SB(); \
            PN1 = __builtin_amdgcn_mfma_f32_32x32x16_bf16(kb2_, qa_, PN1, 0, 0, 0); P_GAPA(PC0, PC1, 5); P_SB(); \
            PN0 = __builtin_amdgcn_mfma_f32_32x32x16_bf16(kc_, qb_, PN0, 0, 0, 0); P_GAPA(PC0, PC1, 6); P_SB(); \
            PN1 = __builtin_amdgcn_mfma_f32_32x32x16_bf16(kd_, qb_, PN1, 0, 0, 0); P_GAPA(PC0, PC1, 7); P_SB(); \
            if (VAR == 0) { PN0 = __builtin_amdgcn_mfma_f32_32x32x16_bf16(P_K5A((t) + 1), q5, PN0, 0, 0, 0); PN1 = __builtin_amdgcn_mfma_f32_32x32x16_bf16(P_K5B((t) + 1), q5, PN1, 0, 0, 0); } \
            asm volatile("" : "+v"(pw_[0]), "+v"(pw_[1]), "+v"(pw_[2]), "+v"(pw_[3]), "+v"(sacc_));        \
        } \
        l += sacc_; \
        if (!STREAM) { if (fullq_) P_DMAK((t) + 3); }        \
        if (nxtv_) P_SM1(PN0, PN1, (t) + 1, (VAR == 1) ? ((t) + 1 == t0w) : ((VAR == 0) && (P_TILE((t) + 1) == t1w))); \
        P_PRUNE_VOTE(t); \
        if (GRP2) P_STEP_BAR(t);        \
        P_PHASEB(pw_, t, PN0, PN1, true); \
        if (resc_) P_RESCALE(fres_); \
        if (!GRP2) P_STEP_BAR(t); \
    } while (0)
    for (int t = t0; t <= tend; t += 2) {
        P_STEP(PA0, PA1, PB0, PB1, t);
        if (t + 1 <= tend) P_STEP(PB0, PB1, PA0, PA1, t + 1);
    }
    int nt1_ = next_t1; const bf16* nk_ = U.nk; const bf16* nk2_ = U.nk2; const bf16* nv_ = U.nv; const float* nc2_ = U.nc2;
    __attribute__((address_space(3))) int* dynw = (__attribute__((address_space(3))) int*)((lptr)lds + OFF_WSF + 2048 + 128);
    if (VAR == 0) { if (U.qctr != nullptr && threadIdx.x == 0) dynw[0] = qtok; }
    if (!STREAM) asm volatile("s_waitcnt lgkmcnt(0)\n\ts_barrier" ::: "memory");
    if (VAR == 0) { if (U.qctr != nullptr) { const int ni_ = __builtin_amdgcn_readfirstlane(dynw[0]);
            if (ni_ < U.qug) { int qb_, b_, h_; fox_decode(ni_, U.qlnb, U.qgb, qb_, b_, h_); nt1_ = 4 * qb_ + 3; nk_ = U.qproj + (size_t)b_ * SEQ * N_IN + 512 + h_ * 64; nk2_ = nk_; nv_ = nk_ + 512; nc2_ = (const float*)(U.qck + (size_t)(b_ * 8 + h_) * SEQ * 16); }
            else nt1_ = -1; } }
    if (!STREAM) { if (nt1_ >= 0) { P_DMAK3(0, nt1_, nk_, nk2_, nc2_); P_DMAV3(0, nt1_, nv_); if (nt1_ >= 1) P_DMAK3(1, nt1_, nk_, nk2_, nc2_); } }
    if (!STREAM && nt1_ < 0) asm volatile("s_waitcnt vmcnt(0)" ::: "memory");
#undef P_STEP_BAR
#undef P_PHASEB
#undef P_RESCALE
#undef P_TILE
#undef P_TILE2
#undef P_DMAK2
#undef P_DMAK3
#undef P_DMAV3
#undef P_DMAV2
#undef P_INR
#undef P_PRUNE_VOTE
#undef P_PRUNE_READ
#undef P_SLOT
#undef P_DMAK
#undef P_DMAV
#undef P_SB
#undef P_QK
#undef P_SM1
#undef P_CINIT
#undef P_K5A
#undef P_K5B
#undef P_GAPA
#undef P_EXP4
#undef P_STEP
#undef P_QF
}

template <int DVB> __device__ __forceinline__ void normalize_o(f32x16 (&o)[DVB], float l, __attribute__((address_space(3))) float* wsf, int r32, int hi) {
    const float lt = xhalf_sum(l);
    if (hi == 0) wsf[32 + r32] = __builtin_amdgcn_rcpf(lt);
    asm volatile("s_waitcnt lgkmcnt(0)" ::: "memory");
#pragma unroll
    for (int r = 0; r < 16; ++r) { const float il = wsf[32 + crow(r, hi)];
#pragma unroll
        for (int d = 0; d < DVB; ++d) o[d][r] *= il; }
}
template <int DVB> __device__ __forceinline__ void store_o(const f32x16 (&o)[DVB], LAS unsigned char* lds, int wave_slot, bf16* dst, int dpitch, int lane) {
    const int r32 = lane & 31, hi = lane >> 5;
    __attribute__((address_space(3))) bf16* stg = (__attribute__((address_space(3))) bf16*)((lptr)lds + OFF_OST) + wave_slot * (32 * 32 * DVB);
    constexpr int RW = 32 * DVB;
#pragma unroll
    for (int r = 0; r < 16; ++r) { const int orow = crow(r, hi);
#pragma unroll
        for (int d = 0; d < DVB; ++d) stg[orow * RW + d * 32 + r32] = (bf16)f2bf(o[d][r]); }
    asm volatile("s_waitcnt lgkmcnt(0)" ::: "memory");
    constexpr int CPR = RW / 8;
#pragma unroll
    for (int i = 0; i < (32 * CPR) / 64; ++i) { const int idx = i * 64 + lane, row = idx / CPR, ch = idx % CPR;
        const u32x4v v = *(const __attribute__((address_space(3))) u32x4v*)(stg + row * RW + ch * 8);
        *(u32x4v*)(dst + (unsigned)(row * dpitch + ch * 8)) = v; }
    asm volatile("s_waitcnt lgkmcnt(0)" ::: "memory");
}

__device__ __forceinline__ void attn0_fox(Frame& F, const Args& a) {
    const int wave = F.wave;
    unsigned long long stamp_acc[6] = {0, 0, 0, 0, 0, 0}; unsigned long long stamp_last = 0;
    unsigned char* ws = a.ws;
    const bf16* proj = (const bf16*)(ws + WS_BIG); bf16* mix = (bf16*)(ws + WS_MIX); const float* c2 = (const float*)(ws + WS_C2);
    __attribute__((address_space(3))) float* wsf = (__attribute__((address_space(3))) float*)((lptr)F.lds + OFF_WSF + wave * 256);
    __attribute__((address_space(3))) float* lutb = (__attribute__((address_space(3))) float*)((lptr)F.lds + OFF_LUT);
    float bqk; { float gq = 0.f, gk = 0.f; for (int i = 0; i < 64; ++i) { gq = fmaxf(gq, fabsf(a.in[5][i])); gk = fmaxf(gk, fabsf(a.in[6][i])); } bqk = 64.0f * 1.008f * (0.125f * LOG2E_F) * gq * gk; }
    const int lng = ((F.G & 7) == 0 && (F.G >> 3) <= 128) ? 3 : 0, gsz = F.G >> lng, lnb = 4 - lng, ug = 64 << lnb;
    const int g = F.vcu / gsz, gb = g << lnb;
    unsigned* qctr = (unsigned*)(F.ctl + CW_FOXQ) + g * 64;
    __attribute__((address_space(3))) int* dynw = (__attribute__((address_space(3))) int*)((lptr)F.lds + OFF_WSF + 2048 + 128);
    int cur = F.vcu - g * gsz, qg = g; bool first = true;
    const int ngr = 1 << lng;
#define FOX_QP(qb_, b_, h_) (proj + ((size_t)(b_) * SEQ + (qb_) * 256 + 32 * wave) * N_IN + (h_) * 64)
    bf16x8 qreg[4];
    if (cur < ug) { int qb, b, h; fox_decode(cur, lnb, gb, qb, b, h); load_q(qreg, FOX_QP(qb, b, h), N_IN, F.lane); }
#pragma unroll 1
    while (cur < ug) {
        const int cgb = qg << lnb;
        int qb, b, h; fox_decode(cur, lnb, cgb, qb, b, h);
        const size_t rowb = (size_t)b * SEQ; const int bh = b * 8 + h;
        int lane = F.lane; asm volatile("" : "+v"(lane));
        const int q0 = qb * 256, qw = q0 + 32 * wave;
        UnitDesc U; U.pitch = N_IN; U.q = nullptr; U.k = proj + rowb * N_IN + 512 + h * 64; U.k2 = U.k; U.v = proj + rowb * N_IN + 1024 + h * 64;
        U.c2 = (const float*)((const char*)(ws + WS_CKREC) + (size_t)bh * SEQ * 16); U.c2f = c2 + (size_t)bh * SEQ; U.t0 = 0; U.t1 = (q0 + 255) / 64; U.q0 = q0;
        U.nk = U.k; U.nk2 = U.k; U.nv = U.v; U.nc2 = U.c2;
        U.qctr = (unsigned*)(F.ctl + CW_FOXQ) + qg * 64; U.qbase = gsz; U.qlnb = lnb; U.qgb = cgb; U.qug = ug; U.qproj = proj; U.qck = (const char*)(ws + WS_CKREC);
        f32x16 o[2]; o[0] = f32x16{}; o[1] = f32x16{}; float mhat = 0.f, l = 0.f;
        if (wave >= 4) unit_loop_p<0, 2, false, true>(F.lds, U, qw, o, mhat, l, lutb, bqk, 0, wave, lane, stamp_acc, stamp_last, qreg, -1, !first, -1);
        else unit_loop_p<0, 2, false, false>(F.lds, U, qw, o, mhat, l, lutb, bqk, 0, wave, lane, stamp_acc, stamp_last, qreg, -1, !first, -1);
        int nxt = __builtin_amdgcn_readfirstlane(dynw[0]);
        int lane2 = F.lane; asm volatile("" : "+v"(lane2));
        if (nxt < ug) { int qbn, bn, hn; fox_decode(nxt, lnb, cgb, qbn, bn, hn); load_q(qreg, FOX_QP(qbn, bn, hn), N_IN, lane2); }
        normalize_o<2>(o, l, wsf, lane2 & 31, lane2 >> 5);
        store_o<2>(o, F.lds, wave, mix + (rowb + qw) * DM + h * 64, DM, lane2);
        asm volatile("s_waitcnt lgkmcnt(0)\n\ts_barrier" ::: "memory");
        first = false;
        if (nxt >= ug && ngr > 1) {
            for (int rnd = 0; rnd < ngr && nxt >= ug; ++rnd) {
                if (F.tid == 0) {
                    int best = -1; unsigned bc = 0xffffffffu;
                    for (int k = 0; k < ngr; ++k) { const unsigned c = __hip_atomic_load((unsigned*)(F.ctl + CW_FOXQ) + k * 64, __ATOMIC_RELAXED, __HIP_MEMORY_SCOPE_AGENT); if (c < bc) { bc = c; best = k; } }
                    int got = 0x7fffffff;
                    if (best >= 0 && gsz + (int)bc < ug) got = gsz + (int)__hip_atomic_fetch_add((unsigned*)(F.ctl + CW_FOXQ) + best * 64, 1u, __ATOMIC_RELAXED, __HIP_MEMORY_SCOPE_AGENT);
                    else best = -1;
                    dynw[2 + 2 * (rnd & 1)] = got; dynw[3 + 2 * (rnd & 1)] = best;
                }
                asm volatile("s_waitcnt vmcnt(0) lgkmcnt(0)\n\ts_barrier" ::: "memory");
                const int got = __builtin_amdgcn_readfirstlane(dynw[2 + 2 * (rnd & 1)]), vg = __builtin_amdgcn_readfirstlane(dynw[3 + 2 * (rnd & 1)]);
                if (vg < 0) break;
                if (got < ug) { nxt = got; qg = vg; }
            }
            if (nxt < ug) { int qbn, bn, hn; fox_decode(nxt, lnb, qg << lnb, qbn, bn, hn); load_q(qreg, FOX_QP(qbn, bn, hn), N_IN, F.lane); first = true; }
        }
        cur = nxt;
    }
#undef FOX_QP
#if defined(PROBE_STEPS)
    if (blockIdx.x == 0 && F.tid == 0) { ((float*)(a.ws + WS_GT))[2048] = 0.08f + 0.16f * ((float)stamp_acc[0] / (float)stamp_acc[1]); }
#endif
#if defined(PROBE_CYC)
    if (blockIdx.x == 0 && F.tid == 0) { ((float*)(a.ws + WS_GT))[2048] = 0.08f + 0.16f * (((float)stamp_acc[2] / (float)stamp_acc[0]) / 8000.0f); }
#endif
#if defined(PROBE_STAMP)
    if (blockIdx.x == 0 && F.tid == 0) { float tot = 0.f; for (int k = 0; k < 5; ++k) tot += (float)stamp_acc[k]; ((float*)(a.ws + WS_GT))[2048] = 0.08f + 0.16f * ((float)stamp_acc[PROBE_STAMP] / tot); }
#endif
}
__device__ __forceinline__ void attn0_diff(Frame& F, const Args& a) {
    const int wave = F.wave;
    unsigned long long stamp_acc[6] = {0, 0, 0, 0, 0, 0}; unsigned long long stamp_last = 0;
    unsigned char* ws = a.ws;
    const bf16* proj = (const bf16*)(ws + WS_BIG); bf16* mix = (bf16*)(ws + WS_MIX);
    __attribute__((address_space(3))) float* wsf = (__attribute__((address_space(3))) float*)((lptr)F.lds + OFF_WSF + wave * 256);
    __attribute__((address_space(3))) float* lutb = (__attribute__((address_space(3))) float*)((lptr)F.lds + OFF_LUT);
    for (int i = F.tid; i < 4 * LUTN; i += NWAVES * 64) { const int h = i / LUTN, e = i % LUTN, d = e - LUTZ; lutb[i] = d < 0 ? NEG_INF : a.in[1][(d < 128 ? kBucket[d] : 31) * 16 + h] * LOG2E_F; }
    __attribute__((address_space(3))) float* parm = lutb + 4 * LUTN;
    if (F.tid == 0) { float s1 = 0.f, s2 = 0.f; for (int i = 0; i < 64; ++i) { s1 += a.in[9][i] * a.in[10][i]; s2 += a.in[11][i] * a.in[12][i]; } parm[0] = expf(s1) - expf(s2) + 0.2f; }
    if (F.tid < 128) parm[4 + F.tid] = a.in[13][F.tid] * 0.8f;
    __syncthreads();
    for (int vv = F.vcu; vv < 256; vv += F.G) {
        const int bh = vv >> 2, b = bh >> 2, h = bh & 3, jj = vv & 3;
        const size_t rowb = (size_t)b * SEQ;
        const int mp = wave >> 2, qs = wave & 3;
#define DIFF_QB(i) (4 * (i) + ((((i) & 1) != 0) ? 3 - jj : jj))
#define DIFF_QP(i) (proj + (rowb + DIFF_QB(i) * 128 + 32 * qs) * N_IN + 1536 + h * 128 + mp * 64)
        bf16x8 qreg[4]; load_q(qreg, DIFF_QP(0), N_IN, F.lane);
#pragma unroll 1
        for (int i = 0; i < 4; ++i) {
            const int qb = DIFF_QB(i);
            int lane = F.lane; asm volatile("" : "+v"(lane));
            const int q0 = qb * 128, qw = q0 + 32 * qs;
            UnitDesc U; U.qctr = nullptr; U.pitch = N_IN; U.q = nullptr; U.k = proj + rowb * N_IN + 2048 + h * 128; U.k2 = U.k + 64; U.v = proj + rowb * N_IN + 2560 + h * 128;
            U.c2 = nullptr; U.c2f = nullptr; U.t0 = 0; U.t1 = (q0 + 127) / 64; U.q0 = q0; U.nk = U.k; U.nk2 = U.k2; U.nv = U.v; U.nc2 = nullptr;
            f32x16 o[4]; o[0] = f32x16{}; o[1] = f32x16{}; o[2] = f32x16{}; o[3] = f32x16{}; float mhat = 0.f, l = 0.f;
            { const int nt1 = (i + 1 < 4) ? (DIFF_QB(i + 1) * 128 + 127) / 64 : -1; const float b31v = lutb[h * LUTN + LUTZ + 128];
              unit_loop_p<1, 4, false, false>(F.lds, U, qw, o, mhat, l, lutb + h * LUTN, b31v, mp, wave, lane, stamp_acc, stamp_last, qreg, -1, i > 0, nt1); }
            int lane2 = F.lane; asm volatile("" : "+v"(lane2));
            if (i + 1 < 4) load_q(qreg, DIFF_QP(i + 1), N_IN, lane2);
            normalize_o<4>(o, l, wsf, lane2 & 31, lane2 >> 5);
            __attribute__((address_space(3))) unsigned* ex = (__attribute__((address_space(3))) unsigned*)((lptr)F.lds + 65536) + qs * 2048;
            if (mp == 1) {
#pragma unroll
                for (int d = 0; d < 4; ++d)
#pragma unroll
                    for (int r = 0; r < 8; ++r) ex[(d * 8 + r) * 64 + lane2] = cvtpk(o[d][2 * r], o[d][2 * r + 1]);
            }
            asm volatile("s_waitcnt lgkmcnt(0)\n\ts_barrier" ::: "memory");
            if (mp == 0) {
                const float lam = parm[0]; float sub[4];
#pragma unroll
                for (int d = 0; d < 4; ++d) sub[d] = parm[4 + d * 32 + (lane2 & 31)];
                float ss[16];
#pragma unroll
                for (int r = 0; r < 16; ++r) ss[r] = 0.f;
#pragma unroll
                for (int d = 0; d < 4; ++d)
#pragma unroll
                    for (int r = 0; r < 8; ++r) { const unsigned w = ex[(d * 8 + r) * 64 + lane2];
                        const float v0 = o[d][2 * r] - lam * __builtin_bit_cast(float, w << 16), v1 = o[d][2 * r + 1] - lam * __builtin_bit_cast(float, w & 0xffff0000u);
                        o[d][2 * r] = v0; o[d][2 * r + 1] = v1; ss[2 * r] += v0 * v0; ss[2 * r + 1] += v1 * v1; }
#pragma unroll
                for (int r = 0; r < 16; ++r) {
                    float s = ss[r];
                    s += __shfl_xor(s, 1); s += __shfl_xor(s, 2); s += __shfl_xor(s, 4); s += __shfl_xor(s, 8); s += __shfl_xor(s, 16);
                    const float rn = __builtin_amdgcn_rsqf(s * (1.0f / 128.0f) + 1e-6f);
#pragma unroll
                    for (int d = 0; d < 4; ++d) o[d][r] *= rn * sub[d];
                }
                store_o<4>(o, F.lds, qs, mix + (rowb + qw) * DM + 512 + h * 128, DM, lane2);
            }
            asm volatile("s_waitcnt lgkmcnt(0)\n\ts_barrier" ::: "memory");
        }
#undef DIFF_QB
#undef DIFF_QP
    }
}

__device__ __forceinline__ void attn1_phase(Frame& F, const Args& a) {
    const int wave = F.wave;
    unsigned long long stamp_acc[6] = {0, 0, 0, 0, 0, 0}; unsigned long long stamp_last = 0;
    unsigned char* ws = a.ws;
    const bf16* qkv = (const bf16*)(ws + WS_BIG); bf16* mix = (bf16*)(ws + WS_MIX);
    __attribute__((address_space(3))) float* wsf = (__attribute__((address_space(3))) float*)((lptr)F.lds + OFF_WSF + wave * 256);
    __attribute__((address_space(3))) float* lutb = (__attribute__((address_space(3))) float*)((lptr)F.lds + OFF_LUT);
    const unsigned lds0 = (unsigned)(uintptr_t)F.lds;
    for (int vv = F.vcu; vv < 256; vv += F.G) {
        const int bk = vv >> 2, b = bk >> 2, kvh = bk & 3, qb0 = 8 * (vv & 3), qbl = qb0 + 7;
        const size_t rowb = (size_t)b * SEQ;
        __syncthreads();
        for (int i = F.tid; i < 4 * LUTN; i += NWAVES * 64) { const int h = kvh * 4 + i / LUTN, e = i % LUTN, d = e - LUTZ; lutb[i] = (d < 0 || d >= 128) ? NEG_INF : a.in[1][kBucket[d] * 16 + h] * LOG2E_F; }
        const bf16* kbase = qkv + rowb * N_QKV + 1024 + kvh * 64; const bf16* vbase = qkv + rowb * N_QKV + 1280 + kvh * 64;
#define SWA_DMA(t) do { int ln_ = F.lane; asm volatile("" : "+v"(ln_)); \
            const unsigned ks_ = (unsigned)(((t) * 64 + ln_) * N_QKV + wave * 8), vs_ = (unsigned)(((t) * 64 + 16 * (wave & 3) + (ln_ >> 2)) * N_QKV + (wave >> 2) * 32 + (ln_ & 3) * 8); \
            const unsigned sd_ = (unsigned)__builtin_amdgcn_readfirstlane((int)(lds0 + (unsigned)wave * 1024u + ((unsigned)(t) % 6u) * 16384u)); \
            glds16(kbase + ks_, sd_); glds16(vbase + vs_, sd_ + 8192u); } while (0)
        { const int ta = qb0 >= 2 ? qb0 - 2 : 0, tb = qb0 + 2;
          for (int t = ta; t <= tb; ++t) SWA_DMA(t); }
        asm volatile("s_waitcnt vmcnt(0)" ::: "memory");
        __syncthreads();
        const int g = wave >> 1, head = kvh * 4 + g;
#define SWA_QP(i) (qkv + (rowb + (qb0 + (i)) * 64 + 32 * (wave & 1)) * N_QKV + head * 64)
        bf16x8 qreg[4]; load_q(qreg, SWA_QP(0), N_QKV, F.lane);
#pragma unroll 1
        for (int i = 0; i < 8; ++i) {
            int lane = F.lane; asm volatile("" : "+v"(lane));
            const int qb = qb0 + i, q0 = qb * 64, qw = q0 + 32 * (wave & 1);
            UnitDesc U; U.qctr = nullptr; U.pitch = N_QKV; U.q = nullptr; U.k = kbase; U.k2 = kbase; U.v = vbase;
            U.c2 = nullptr; U.c2f = nullptr; U.t0 = qb >= 2 ? qb - 2 : 0; U.t1 = qb; U.q0 = q0; U.nk = kbase; U.nk2 = kbase; U.nv = vbase; U.nc2 = nullptr;
            f32x16 o[2]; o[0] = f32x16{}; o[1] = f32x16{};
            float mhat = a.in[19][head] * LOG2E_F, l = ((lane >> 5) == 0) ? 1.0f : 0.0f;
            unit_loop_p<2, 2, true>(F.lds, U, qw, o, mhat, l, lutb + g * LUTN, 0.f, 0, wave, lane, stamp_acc, stamp_last, qreg, (qb + 3 <= qbl) ? qb + 3 : -1);
            int lane2 = F.lane; asm volatile("" : "+v"(lane2));
            asm volatile("s_waitcnt vmcnt(0)" ::: "memory");
            if (i + 1 < 8) load_q(qreg, SWA_QP(i + 1), N_QKV, lane2);
            normalize_o<2>(o, l, wsf, lane2 & 31, lane2 >> 5);
            store_o<2>(o, F.lds, wave, mix + (rowb + qw) * DM + head * 64, DM, lane2);
            asm volatile("s_waitcnt lgkmcnt(0)\n\ts_barrier" ::: "memory");
        }
#undef SWA_QP
#undef SWA_DMA
    }
}
}

#if defined(PROBE_NOATOM)
#define PROBE_NOATOM_PTR ((float*)nullptr)
#else
#define PROBE_NOATOM_PTR (ssq + 4 * M)
#endif
#ifndef WGM_P1
#define WGM_P1 4
#endif
#ifndef WGM_P6
#define WGM_P6 4
#endif
#ifndef WGM_UP
#define WGM_UP 4
#endif
#ifndef WGM_OUT
#define WGM_OUT 4
#endif
#ifndef WGM_DN
#define WGM_DN 4
#endif
#ifndef ALIGN_SWIGLU
#define ALIGN_SWIGLU true
#endif
#ifndef ALIGN_QKV
#define ALIGN_QKV true
#endif
__global__ void __launch_bounds__(NWAVES * 64, 2) skel_fwd(Args args) {
    extern __shared__ __attribute__((aligned(16))) unsigned char lds[];
    Frame F;
    F.lds = (LAS unsigned char*)lds;
    F.MISC = (volatile LAS unsigned*)(F.lds + MISC_OFF);
    F.tid = threadIdx.x; F.lane = F.tid & 63; F.wave = __builtin_amdgcn_readfirstlane(F.tid >> 6);
    F.G = gridDim.x; { const int bx = blockIdx.x; F.vcu = (F.G % 8 == 0) ? (bx % 8) * (F.G / 8) + bx / 8 : bx; }
    unsigned char* ws = args.ws;
    F.ctl = (gu32*)(ws + WS_CTL);
    for (int u = F.tid; u < (LDS_BYTES - LDSCTL_OFF) / 4; u += NWAVES * 64) ((LAS unsigned*)(F.lds + LDSCTL_OFF))[u] = 0u;
    __syncthreads();
    XcdBarrier bar; bar.bar = (unsigned*)(F.ctl + CW_BAR); bar.x = 0; bar.st = nullptr;
    if (args.use_bar) bar = xcd_barrier_post((unsigned*)(F.ctl + CW_BAR), F.MISC + 8);
#if defined(PROBE_DOUBLE_BAR)
#define GRID_BAR() do { if (args.use_bar) { xcd_barrier(bar); xcd_barrier(bar); } } while (0)
#else
#define GRID_BAR() do { if (args.use_bar) xcd_barrier(bar); } while (0)
#endif
    const int lo = args.ph_lo, hi = args.ph_hi;
#ifndef PHASE_MASK
#define PHASE_MASK 0x7ff
#endif
#define IN(k) (((PHASE_MASK >> (k)) & 1) && lo <= (k) && (k) < hi)
#define BOTH(k) (IN(k) && IN((k) + 1))
#define NREP(k) (1 + ((REP_MASK >> (k)) & 1))
#define REPEAT(k) _Pragma("unroll") for (int rep = NREP(k) - 1; rep >= 0; --rep)
    bf16* wb = (bf16*)(ws + WS_W);
    float* ssq = (float*)(ws + WS_SSQ);
    bf16* xb = (bf16*)(ws + WS_XB); bf16* big = (bf16*)(ws + WS_BIG); bf16* mix = (bf16*)(ws + WS_MIX);
    const int G = F.G, cid = (int)blockIdx.x;

    if (IN(0)) { REPEAT(0) { p0_prologue(F, args); __syncthreads(); } if (BOTH(0)) GRID_BAR(); }
    if (IN(1)) {
        REPEAT(1) {
        cumsum_phase(F, args);
        pg8::Gemm g{xb, (const bf16*)((const char*)wb + WO_IN), M, N_IN, DM}; pg8::StaticOrder S; S.init(M, N_IN, G, cid, WGM_P1);
        pg8::EpiQKV<0> E{big, N_IN, ssq, (const float*)(ws + WS_GT), F.lds};
        pg8::gemm_phase<pg8::EpiQKV<0>, pg8::StaticOrder, ALIGN_QKV, true>(F.lds + RING_OFF, g, S, E);
        }
        if (BOTH(1)) GRID_BAR();
    }
    if (IN(2)) {
#if defined(PROBE_IMBAL)
#define IMB_BEGIN() unsigned long long tb_; asm volatile("s_memtime %0\n\ts_waitcnt lgkmcnt(0)" : "=s"(tb_) :: "memory")
#define IMB_END() do { __syncthreads(); unsigned long long te_; asm volatile("s_memtime %0\n\ts_waitcnt lgkmcnt(0)" : "=s"(te_) :: "memory"); if (F.tid == 0) { const unsigned d_ = (unsigned)(te_ - tb_); atomicMax((unsigned*)(F.ctl + 20000), d_); atomicAdd((unsigned*)(F.ctl + 20064), d_); } } while (0)
#else
#define IMB_BEGIN() do {} while (0)
#define IMB_END() do {} while (0)
#endif
        REPEAT(2) {
#if defined(PROBE_IMBAL) && PROBE_IMBAL == 1
            { IMB_BEGIN(); att::attn0_fox(F, args); IMB_END(); } att::attn0_diff(F, args);
#elif defined(PROBE_IMBAL) && PROBE_IMBAL == 2
            att::attn0_fox(F, args); { IMB_BEGIN(); att::attn0_diff(F, args); IMB_END(); }
#else
            REPEAT(11) att::attn0_fox(F, args); REPEAT(12) att::attn0_diff(F, args);
#endif
        }
        if (BOTH(2)) GRID_BAR();
    }
    if (IN(3)) {
        REPEAT(3) {
        pg8::Gemm g{mix, (const bf16*)((const char*)wb + WO_EO), M, DM, DM}; pg8::StaticOrder S; S.init(M, DM, G, cid, WGM_OUT);
#if defined(NULL_EPI_PROBE3)
        if (rep) { pg8::EpiNull E0; pg8::gemm_phase<pg8::EpiNull, pg8::StaticOrder, true, true>(F.lds + RING_OFF, g, S, E0); } else
#endif
        { pg8::EpiRes<false> E{xb, rep ? (bf16*)(ws + WS_R1) : xb, nullptr, rep ? ssq + 16 * M : ssq + 4 * M, (LAS float*)(F.lds + RING_BYTES)};
        pg8::gemm_phase<pg8::EpiRes<false>, pg8::StaticOrder, true, true>(F.lds + RING_OFF, g, S, E); }
        }
        if (BOTH(3)) GRID_BAR();
    }
    if (IN(4)) {
        REPEAT(4) {
        pg8::Gemm g{xb, (const bf16*)((const char*)wb + WO_UP0), M, N_UP, DM}; pg8::StaticOrder S; S.init(M, N_UP, G, cid, WGM_UP);
#if defined(NULL_EPI_PROBE)
        if (rep) { pg8::EpiNull E0; pg8::gemm_phase<pg8::EpiNull, pg8::StaticOrder, true, true>(F.lds + RING_OFF, g, S, E0); } else
#endif
        { pg8::EpiSwiGLU E{big, FFH, ssq + 4 * M, F.lds};
        pg8::gemm_phase<pg8::EpiSwiGLU, pg8::StaticOrder, ALIGN_SWIGLU, true>(F.lds + RING_OFF, g, S, E); }
        }
        if (BOTH(4)) GRID_BAR();
    }
    if (IN(5)) {
        REPEAT(5) {
        pg8::Gemm g{big, (const bf16*)((const char*)wb + WO_DN0), M, DM, FFH}; pg8::StaticOrder S; S.init(M, DM, G, cid, WGM_DN);
        pg8::EpiRes<false> E{xb, rep ? (bf16*)(ws + WS_R1) : xb, nullptr, rep ? ssq + 16 * M : ssq + 8 * M, (LAS float*)(F.lds + RING_BYTES)};
        pg8::gemm_phase<pg8::EpiRes<false>, pg8::StaticOrder, true, true>(F.lds + RING_OFF, g, S, E);
        }
        if (BOTH(5)) GRID_BAR();
    }
    if (IN(6)) {
        REPEAT(6) {
        pg8::Gemm g{xb, (const bf16*)((const char*)wb + WO_QKV), M, N_QKV, DM}; pg8::StaticOrder S; S.init(M, N_QKV, G, cid, WGM_P6);
        pg8::EpiQKV<1> E{big, N_QKV, ssq + 8 * M, (const float*)(ws + WS_GT) + 12 * 64, F.lds};
        pg8::gemm_phase<pg8::EpiQKV<1>, pg8::StaticOrder, ALIGN_QKV, true>(F.lds + RING_OFF, g, S, E);
        }
        if (BOTH(6)) GRID_BAR();
    }
    if (IN(7)) {
#if defined(PROBE_IMBAL) && PROBE_IMBAL == 3
        { IMB_BEGIN(); att::attn1_phase(F, args); IMB_END(); }
#else
        REPEAT(7) att::attn1_phase(F, args);
#endif
        if (BOTH(7)) GRID_BAR();
    }
    if (IN(8)) {
#if defined(PROBE_IMBAL)
        if (blockIdx.x == 0 && F.tid == 0) { const float mx_ = (float)__hip_atomic_load((unsigned*)(F.ctl + 20000), __ATOMIC_RELAXED, __HIP_MEMORY_SCOPE_AGENT), sm_ = (float)__hip_atomic_load((unsigned*)(F.ctl + 20064), __ATOMIC_RELAXED, __HIP_MEMORY_SCOPE_AGENT);
            ((float*)(ws + WS_GT))[2048] = 0.08f + 0.16f * (1.0f - sm_ / (mx_ * (float)gridDim.x)); }
#endif
        REPEAT(8) {
        pg8::Gemm g{mix, (const bf16*)((const char*)wb + WO_OO), M, DM, DM}; pg8::StaticOrder S; S.init(M, DM, G, cid, WGM_OUT);
        pg8::EpiRes<false> E{xb, rep ? (bf16*)(ws + WS_R1) : xb, nullptr, rep ? ssq + 16 * M : ssq + 12 * M, (LAS float*)(F.lds + RING_BYTES)};
        pg8::gemm_phase<pg8::EpiRes<false>, pg8::StaticOrder, true, true>(F.lds + RING_OFF, g, S, E);
        }
        if (BOTH(8)) GRID_BAR();
    }
    if (IN(9)) {
        REPEAT(9) {
        pg8::Gemm g{xb, (const bf16*)((const char*)wb + WO_UP1), M, N_UP, DM}; pg8::StaticOrder S; S.init(M, N_UP, G, cid, WGM_UP);
        pg8::EpiSwiGLU E{big, FFH, ssq + 12 * M, F.lds};
        pg8::gemm_phase<pg8::EpiSwiGLU, pg8::StaticOrder, ALIGN_SWIGLU, true>(F.lds + RING_OFF, g, S, E);
        }
        if (BOTH(9)) GRID_BAR();
    }
    if (IN(10)) {
        REPEAT(10) {
        pg8::Gemm g{big, (const bf16*)((const char*)wb + WO_DN1), M, DM, FFH}; pg8::StaticOrder S; S.init(M, DM, G, cid, WGM_DN);
        pg8::EpiRes<true> E{xb, nullptr, rep ? (float*)(ws + WS_R1) : args.out, (float*)(ws + WS_GT) + 2048, (LAS float*)(F.lds + RING_BYTES)};
        pg8::gemm_phase<pg8::EpiRes<true>, pg8::StaticOrder, true, true>(F.lds + RING_OFF, g, S, E);
        }
    }
#undef IN
#undef BOTH
#undef NREP
#undef REPEAT
#undef GRID_BAR
}

#if MK_MODE == 0
namespace simple {
constexpr int PP = N_IN;
__global__ __launch_bounds__(128) void fox_k(const bf16* __restrict__ proj, const float* __restrict__ c2, bf16* __restrict__ mix) {
    const int h = blockIdx.y, b = blockIdx.z, q0 = blockIdx.x * 128, qp = q0 + threadIdx.x;
    const size_t rb = (size_t)b * SEQ;
    const float* cc = c2 + (size_t)(b * 8 + h) * SEQ;
    float q[64], acc[64];
    const bf16* qr = proj + (rb + qp) * PP + h * 64;
#pragma unroll
    for (int d = 0; d < 64; ++d) { q[d] = bf2f(qr[d]); acc[d] = 0.f; }
    float m = -1e30f, l = 0.f;
    const int kend = q0 + 128;
    for (int k = 0; k < kend; ++k) {
        const bf16* kr = proj + (rb + k) * PP + 512 + h * 64;
        const bf16* vr = proj + (rb + k) * PP + 1024 + h * 64;
        float s = 0.f;
#pragma unroll
        for (int d = 0; d < 64; ++d) s = fmaf(q[d], bf2f(kr[d]), s);
        s -= cc[k];
        if (k <= qp) {
            const float mn = fmaxf(m, s);
            const float corr = exp2f(m - mn), p = exp2f(s - mn);
            l = l * corr + p;
#pragma unroll
            for (int d = 0; d < 64; ++d) acc[d] = fmaf(acc[d], corr, p * bf2f(vr[d]));
            m = mn;
        }
    }
    const float il = 1.0f / l;
    bf16* o = mix + (rb + qp) * DM + h * 64;
#pragma unroll
    for (int d = 0; d < 64; ++d) o[d] = (bf16)f2bf(acc[d] * il);
}
__global__ __launch_bounds__(256) void diff_k(const bf16* __restrict__ proj, const float* __restrict__ table, float* __restrict__ dtmp) {
    __shared__ float lut[129];
    const int h = blockIdx.y, b = blockIdx.z, q0 = blockIdx.x * 64;
    if (threadIdx.x < 128) lut[threadIdx.x] = table[kBucket[threadIdx.x] * 16 + h] * LOG2E_F;
    if (threadIdx.x == 128) lut[128] = table[31 * 16 + h] * LOG2E_F;
    __syncthreads();
    const size_t rb = (size_t)b * SEQ;
    const int w = threadIdx.x >> 6, lane = threadIdx.x & 63, m_ = w >> 1, vh = w & 1, qp = q0 + lane;
    float q[64], acc[64];
    const bf16* qr = proj + (rb + qp) * PP + 1536 + h * 128 + m_ * 64;
#pragma unroll
    for (int d = 0; d < 64; ++d) { q[d] = bf2f(qr[d]); acc[d] = 0.f; }
    float m = -1e30f, l = 0.f;
    const int kend = q0 + 64;
    for (int k = 0; k < kend; ++k) {
        const bf16* kr = proj + (rb + k) * PP + 2048 + h * 128 + m_ * 64;
        const bf16* vr = proj + (rb + k) * PP + 2560 + h * 128 + vh * 64;
        float s = 0.f;
#pragma unroll
        for (int d = 0; d < 64; ++d) s = fmaf(q[d], bf2f(kr[d]), s);
        if (k <= qp) {
            const int dl = qp - k;
            s += lut[dl < 128 ? dl : 128];
            const float mn = fmaxf(m, s);
            const float corr = exp2f(m - mn), p = exp2f(s - mn);
            l = l * corr + p;
#pragma unroll
            for (int d = 0; d < 64; ++d) acc[d] = fmaf(acc[d], corr, p * bf2f(vr[d]));
            m = mn;
        }
    }
    const float il = 1.0f / l;
    float* o = dtmp + (size_t)m_ * M * 512 + (rb + qp) * 512 + h * 128 + vh * 64;
#pragma unroll
    for (int d = 0; d < 64; ++d) o[d] = acc[d] * il;
}
__global__ __launch_bounds__(256) void diff_combine_k(const float* __restrict__ dtmp, const float* __restrict__ lq1, const float* __restrict__ lk1, const float* __restrict__ lq2,
                                                      const float* __restrict__ lk2, const float* __restrict__ subln, bf16* __restrict__ mix, float lambda_init) {
    const int t = blockIdx.x * blockDim.x + threadIdx.x;
    if (t >= M * 4) return;
    const int row = t >> 2, h = t & 3;
    float s1 = 0.f, s2 = 0.f;
    for (int i = 0; i < 64; ++i) { s1 += lq1[i] * lk1[i]; s2 += lq2[i] * lk2[i]; }
    const float lam = expf(s1) - expf(s2) + lambda_init;
    const float* o0 = dtmp + (size_t)row * 512 + h * 128;
    const float* o1 = dtmp + (size_t)M * 512 + (size_t)row * 512 + h * 128;
    float ss = 0.f;
    for (int e = 0; e < 128; ++e) { const float d = o0[e] - lam * o1[e]; ss += d * d; }
    const float r = rsqrtf(ss * (1.0f / 128.0f) + 1e-6f);
    bf16* o = mix + (size_t)row * DM + 512 + h * 128;
    for (int e = 0; e < 128; ++e) { const float d = o0[e] - lam * o1[e]; o[e] = (bf16)f2bf(d * r * subln[e] * (1.0f - lambda_init)); }
}
__global__ __launch_bounds__(128) void swa_k(const bf16* __restrict__ qkv, const float* __restrict__ table, const float* __restrict__ sinks, bf16* __restrict__ mix) {
    __shared__ float lut[128];
    const int h = blockIdx.y, kvh = h >> 2, b = blockIdx.z, q0 = blockIdx.x * 128, qp = q0 + threadIdx.x;
    lut[threadIdx.x] = table[kBucket[threadIdx.x] * 16 + h] * LOG2E_F;
    __syncthreads();
    const size_t rb = (size_t)b * SEQ;
    float q[64], acc[64];
    const bf16* qr = qkv + (rb + qp) * N_QKV + h * 64;
#pragma unroll
    for (int d = 0; d < 64; ++d) { q[d] = bf2f(qr[d]); acc[d] = 0.f; }
    float m = sinks[h] * LOG2E_F, l = 1.0f;
    int kbeg = q0 - 127; if (kbeg < 0) kbeg = 0;
    const int kend = q0 + 128;
    for (int k = kbeg; k < kend; ++k) {
        const bf16* kr = qkv + (rb + k) * N_QKV + 1024 + kvh * 64;
        const bf16* vr = qkv + (rb + k) * N_QKV + 1280 + kvh * 64;
        float s = 0.f;
#pragma unroll
        for (int d = 0; d < 64; ++d) s = fmaf(q[d], bf2f(kr[d]), s);
        const int dl = qp - k;
        if (dl >= 0 && dl < 128) {
            s += lut[dl];
            const float mn = fmaxf(m, s);
            const float corr = exp2f(m - mn), p = exp2f(s - mn);
            l = l * corr + p;
#pragma unroll
            for (int d = 0; d < 64; ++d) acc[d] = fmaf(acc[d], corr, p * bf2f(vr[d]));
            m = mn;
        }
    }
    const float il = 1.0f / l;
    bf16* o = mix + (rb + qp) * DM + h * 64;
#pragma unroll
    for (int d = 0; d < 64; ++d) o[d] = (bf16)f2bf(acc[d] * il);
}
}
#endif

extern "C" void kernel_launch(void* const* d_in, const int* in_sizes, int n_in, void* d_out, int out_size, void* d_ws, size_t ws_size, hipStream_t stream) {
    static int grid = 0;
    if (grid == 0) {
        if (n_in != 25 || in_sizes[0] != M * DM || out_size != M * DM || ws_size < WS_END) { fprintf(stderr, "kernel_launch: unexpected shapes / workspace (%d inputs, ws %zu)\n", n_in, ws_size); grid = -1; return; }
        int dev = 0, cus = 0, per_cu = 0;
        if (hipGetDevice(&dev) != hipSuccess || hipDeviceGetAttribute(&cus, hipDeviceAttributeMultiprocessorCount, dev) != hipSuccess) { grid = -1; return; }
        if (hipFuncSetAttribute((const void*)skel_fwd, hipFuncAttributeMaxDynamicSharedMemorySize, LDS_BYTES) != hipSuccess) { grid = -1; return; }
        if (hipOccupancyMaxActiveBlocksPerMultiprocessor(&per_cu, (const void*)skel_fwd, NWAVES * 64, LDS_BYTES) != hipSuccess || per_cu < 1) { fprintf(stderr, "kernel_launch: occupancy query says %d workgroups per CU; nothing launched\n", per_cu); grid = -1; return; }
        (void)hipGetLastError();
        grid = cus;
    }
    if (grid < 0) return;
    (void)hipMemsetAsync((char*)d_ws + WS_CTL, 0, CTL_ZERO_BYTES, stream);
    Args a{};
    for (int i = 0; i < 25; ++i) a.in[i] = (const float*)d_in[i];
    a.out = (float*)d_out; a.ws = (unsigned char*)d_ws;
    a.rep_mask = REP_MASK;
    unsigned char* ws = (unsigned char*)d_ws;
    const float* const* in = a.in;
#if MK_MODE == 0
    a.use_bar = 0;
    auto run = [&](int lo, int hi) { a.ph_lo = lo; a.ph_hi = hi; hipLaunchKernelGGL(skel_fwd, dim3(grid), dim3(NWAVES * 64), LDS_BYTES, stream, a); };
    run(0, 1); run(1, 2);
    hipLaunchKernelGGL(simple::fox_k, dim3(SEQ / 128, 8, NB), dim3(128), 0, stream, (const bf16*)(ws + WS_BIG), (const float*)(ws + WS_C2), (bf16*)(ws + WS_MIX));
    hipLaunchKernelGGL(simple::diff_k, dim3(SEQ / 64, 4, NB), dim3(256), 0, stream, (const bf16*)(ws + WS_BIG), in[1], (float*)(ws + WS_R1));
    hipLaunchKernelGGL(simple::diff_combine_k, dim3(M * 4 / 256), dim3(256), 0, stream, (const float*)(ws + WS_R1), in[9], in[10], in[11], in[12], in[13], (bf16*)(ws + WS_MIX), 0.2f);
    run(3, 4); run(4, 5); run(5, 6); run(6, 7);
    hipLaunchKernelGGL(simple::swa_k, dim3(SEQ / 128, 16, NB), dim3(128), 0, stream, (const bf16*)(ws + WS_BIG), in[1], in[19], (bf16*)(ws + WS_MIX));
    run(8, 9); run(9, 10); run(10, 11);
#elif MK_MODE == 1
    a.use_bar = 0;
    for (int p = 0; p < 11; ++p) { a.ph_lo = p; a.ph_hi = p + 1; hipLaunchKernelGGL(skel_fwd, dim3(grid), dim3(NWAVES * 64), LDS_BYTES, stream, a); }
#else
    a.use_bar = 1; a.ph_lo = 0; a.ph_hi = 11;
    hipLaunchKernelGGL(skel_fwd, dim3(grid), dim3(NWAVES * 64), LDS_BYTES, stream, a);
#endif
}
```

```cpp
#include <hip/hip_runtime.h>
#include <cstdio>
#include <cstdint>
#include <cmath>
#define MK_MODE 2
#define REP_MASK 0
namespace pg8 {
#define PG8_LAS __attribute__((address_space(3)))
typedef unsigned short bf16_t;
typedef short bf16x8 __attribute__((ext_vector_type(8)));
typedef float f32x4 __attribute__((ext_vector_type(4)));
typedef unsigned u32x4 __attribute__((ext_vector_type(4)));
constexpr int BM = 256, BK = 64, HALF = 128, HTB = HALF * BK * 2  , STAGE_BYTES = 8 * HTB, NXCD = 8, WGM = 8;

__host__ __device__ __forceinline__ int lds_byte(int r, int c) { const int st = (r >> 4) * 2 + (c >> 5), rr = r & 15, cc = c & 31, ob = rr * 64 + cc * 2; return st * 1024 + (ob ^ (((ob >> 9) & 1) << 5)); }
__host__ __device__ __forceinline__ void stage_rc(int b, int& R, int& C) { const int st = b / 1024, sb = b % 1024, swz = sb ^ (((sb >> 9) & 1) << 5); R = (st >> 1) * 16 + swz / 64; C = (st & 1) * 32 + (swz % 64) / 2; }
__host__ __device__ __forceinline__ int perm32(int rho) { const int n = rho >> 4, i = rho & 15; return 8 * (i >> 2) + 4 * n + (i & 3); }

struct Unit { int pm, pn; };
struct Gemm { const bf16_t* A; const bf16_t* Bt; int M, N, K; };

struct StaticOrder {
    int nM, nN, nwg, G, c, wgm;
    __host__ __device__ void init(int M, int N, int G_, int c_, int wgm_ = WGM) { nM = M / BM; nN = N / BM; nwg = nM * nN; G = G_; c = c_; wgm = wgm_; }
    __host__ __device__ bool next(int i, Unit& u) const {
        const long L = (long)i * G + c; if (L >= nwg) return false;
        int wgid = (int)L; { const int q = nwg / NXCD, r = nwg % NXCD, xcd = wgid % NXCD, off = wgid / NXCD; wgid = (xcd < r ? xcd * (q + 1) : r * (q + 1) + (xcd - r) * q) + off; }
        const int nig = wgm * nN, gid = wgid / nig, fm = gid * wgm, gsz = (nM - fm) < wgm ? (nM - fm) : wgm;
        u.pm = fm + ((wgid % nig) % gsz); u.pn = (wgid % nig) / gsz; return true;
    }
    __device__ __forceinline__ void a_ready(const Unit&) const {}
    __device__ __forceinline__ void done(const Unit&) const {}
};
template <int NR> struct StaticOrderRev : StaticOrder {
    __host__ __device__ bool next(int i, Unit& u) const { if (i >= NR) return false; return StaticOrder::next(NR - 1 - i, u); }
};

__device__ __forceinline__ unsigned cvt_pk_bf16(float lo, float hi) { unsigned r; asm volatile("v_cvt_pk_bf16_f32 %0, %1, %2" : "=v"(r) : "v"(lo), "v"(hi)); return r; }
typedef float f32x2 __attribute__((ext_vector_type(2)));

constexpr float RMS_EPS = 1e-6f;
constexpr float LOG2E = 1.4426950408889634f;
constexpr float QSCALE = 0.125f * LOG2E;
__device__ __forceinline__ float row_ss(const float* ssq, int row) { const f32x4 p = *(const f32x4*)(ssq + (size_t)row * 4); return (p[0] + p[1]) + (p[2] + p[3]); }

constexpr int PF_SSQ_OFF = 131072, PF_GT_OFF = 135168;
__device__ __forceinline__ void store16_wt(void* p, u32x4 w) { asm volatile("global_store_dwordx4 %0, %1, off sc1\n\ts_nop 1" :: "v"(p), "v"(w) : "memory"); }
__device__ __forceinline__ void pf_issue(const float* ssq, const float* gt, const Unit& u, PG8_LAS unsigned char* lds, int wid, int lane) {
    if (gt != nullptr && wid >= 4) __builtin_amdgcn_global_load_lds((const unsigned*)(gt + (lane & 15) * 4), (PG8_LAS unsigned*)(lds + PF_GT_OFF), 16, 0, 0);
    else __builtin_amdgcn_global_load_lds((const unsigned*)(ssq + ((size_t)(u.pm * BM + (wid & 3) * 64 + lane)) * 4), (PG8_LAS unsigned*)(lds + PF_SSQ_OFF + (wid & 3) * 1024), 16, 0, 0);
}
__device__ __forceinline__ float row_ss_lds(PG8_LAS const unsigned char* lds, int lrow) { const f32x4 p = *(PG8_LAS const f32x4*)(lds + PF_SSQ_OFF + lrow * 16); return (p[0] + p[1]) + (p[2] + p[3]); }

template <int LAYER> struct EpiQKV {
    static constexpr bool PERM = true, AFTER_DRAIN = false, PF = true, A_TILED = false;
    bf16_t* O; int ldc; const float* ssq; const float* gtab; PG8_LAS unsigned char* lds;
    __device__ __forceinline__ void prefetch(const Unit& u, int wid, int lane) const { pf_issue(ssq, gtab + u.pn * 64, u, lds, wid, lane); }
    __device__ __forceinline__ void operator()(const f32x4 (&acc)[2][2][4][2], const Unit& u, int wr, int wc, int fr, int fq) const {
        int kind;
        if (LAYER == 0) kind = (u.pn >> 1) % 3; else kind = u.pn < 4 ? 0 : u.pn - 3;
        const int row0 = u.pm * BM + wr * 64 + fr;
        const int col0 = u.pn * BM + wc * 64 + 8 * fq;
        f32x4 gv[2][2];
#pragma unroll
        for (int bj = 0; bj < 2; ++bj)
#pragma unroll
            for (int n = 0; n < 2; ++n) {
                gv[bj][n] = *(PG8_LAS const f32x4*)(lds + PF_GT_OFF + (32 * bj + 8 * fq + 4 * n) * 4);
            }
        float rsv[8];
#pragma unroll
        for (int q = 0; q < 8; ++q) rsv[q] = row_ss_lds(lds, wr * 64 + fr + (q >> 2) * HALF + (q & 3) * 16);
#pragma unroll
        for (int q = 0; q < 8; ++q) rsv[q] = __builtin_amdgcn_rsqf(rsv[q] * (1.0f / 1024.0f) + RMS_EPS);
#pragma unroll
        for (int ai = 0; ai < 2; ++ai)
#pragma unroll
            for (int m = 0; m < 4; ++m) {
                const int row = row0 + ai * HALF + m * 16;
                const float rs = rsv[ai * 4 + m];
                f32x2 ssv = {0.f, 0.f};
                if (kind < 2) {
#pragma unroll
                    for (int bj = 0; bj < 2; ++bj)
#pragma unroll
                        for (int n = 0; n < 2; ++n) { const f32x4 t = acc[ai][bj][m][n]; const f32x2 t0 = {t[0], t[1]}, t1 = {t[2], t[3]}; ssv = t0 * t0 + ssv; ssv = t1 * t1 + ssv; }
                }
                float sc = rs;
                if (kind < 2) {
                    float ss = (ssv[0] + ssv[1]) * (rs * rs);
                    ss += __shfl_xor(ss, 16); ss += __shfl_xor(ss, 32);
                    sc = rs * __builtin_amdgcn_rsqf(ss * (1.0f / 64.0f) + RMS_EPS);
                }
                const f32x2 scv = {sc, sc};
                f32x4 v[2][2];
#pragma unroll
                for (int bj = 0; bj < 2; ++bj)
#pragma unroll
                    for (int n = 0; n < 2; ++n) {
                        const f32x4 t = acc[ai][bj][m][n], g = gv[bj][n];
                        f32x2 g0 = {g[0], g[1]}, g1 = {g[2], g[3]};
                        if (kind < 2) { g0 = g0 * scv; g1 = g1 * scv; } else { g0 = scv; g1 = scv; }
                        const f32x2 o0 = (f32x2){t[0], t[1]} * g0, o1 = (f32x2){t[2], t[3]} * g1;
                        v[bj][n] = (f32x4){o0[0], o0[1], o1[0], o1[1]};
                    }
                bf16_t* rowp = O + (size_t)row * ldc + col0;
#pragma unroll
                for (int bj = 0; bj < 2; ++bj) {
                    u32x4 w; w.x = cvt_pk_bf16(v[bj][0][0], v[bj][0][1]); w.y = cvt_pk_bf16(v[bj][0][2], v[bj][0][3]); w.z = cvt_pk_bf16(v[bj][1][0], v[bj][1][1]); w.w = cvt_pk_bf16(v[bj][1][2], v[bj][1][3]);
                    *(u32x4*)(rowp + 32 * bj) = w;
                }
            }
    }
};

template <bool FINAL, bool ATILED = false> struct EpiRes {
    static constexpr bool PERM = true, AFTER_DRAIN = false, PF = false, A_TILED = ATILED;
    const bf16_t* res; bf16_t* outb; float* outf; float* ssq; PG8_LAS float* xs;
    __device__ __forceinline__ void operator()(const f32x4 (&acc)[2][2][4][2], const Unit& u, int wr, int wc, int fr, int fq) const {
        const int row0 = u.pm * BM + wr * 64 + fr, col0 = u.pn * BM + wc * 32 + 8 * fq;
#pragma unroll
        for (int ai = 0; ai < 2; ++ai) {
            u32x4 pre[4][2];
#pragma unroll
            for (int m = 0; m < 4; ++m)
#pragma unroll
                for (int bj = 0; bj < 2; ++bj) pre[m][bj] = *(const u32x4*)(res + ((unsigned)(row0 + ai * HALF + m * 16) * 1024u + (unsigned)(col0 + bj * HALF)));
#pragma unroll
            for (int m = 0; m < 4; ++m) {
                const int row = row0 + ai * HALF + m * 16; const unsigned off = (unsigned)row * 1024u + (unsigned)col0;
                f32x2 ssv = {0.f, 0.f};
#pragma unroll
                for (int bj = 0; bj < 2; ++bj) {
                    const unsigned c = off + (unsigned)(bj * HALF);
                    const u32x4 rv = pre[m][bj];
                    f32x4 o0, o1;
                    o0[0] = __builtin_bit_cast(float, rv.x << 16); o0[1] = __builtin_bit_cast(float, rv.x & 0xffff0000u); o0[2] = __builtin_bit_cast(float, rv.y << 16); o0[3] = __builtin_bit_cast(float, rv.y & 0xffff0000u);
                    o1[0] = __builtin_bit_cast(float, rv.z << 16); o1[1] = __builtin_bit_cast(float, rv.z & 0xffff0000u); o1[2] = __builtin_bit_cast(float, rv.w << 16); o1[3] = __builtin_bit_cast(float, rv.w & 0xffff0000u);
                    o0 = o0 + acc[ai][bj][m][0]; o1 = o1 + acc[ai][bj][m][1];
#if defined(PROBE_STAMP) || defined(PROBE_STEPS) || defined(PROBE_CYC) || defined(PROBE_IMBAL)
                    if (FINAL && c == 0) o0[0] += ssq[0];
#endif
                    if (FINAL) { *(f32x4*)(outf + c) = o0; *(f32x4*)(outf + c + 4) = o1; }
                    else {
                        { const f32x2 a0 = {o0[0], o0[1]}, a1 = {o0[2], o0[3]}, a2 = {o1[0], o1[1]}, a3 = {o1[2], o1[3]}; ssv = a0 * a0 + ssv; ssv = a1 * a1 + ssv; ssv = a2 * a2 + ssv; ssv = a3 * a3 + ssv; }
                        u32x4 w; w.x = cvt_pk_bf16(o0[0], o0[1]); w.y = cvt_pk_bf16(o0[2], o0[3]); w.z = cvt_pk_bf16(o1[0], o1[1]); w.w = cvt_pk_bf16(o1[2], o1[3]);
                        *(u32x4*)(outb + c) = w;
                    }
                }
                if (!FINAL) { float ss = ssv[0] + ssv[1]; ss += __shfl_xor(ss, 16); ss += __shfl_xor(ss, 32); if (fq == 0) xs[(ai * HALF + wr * 64 + m * 16 + fr) * 4 + wc] = ss; }
            }
        }
        if (!FINAL) {
            asm volatile("s_waitcnt lgkmcnt(0)\n\ts_barrier" ::: "memory");
            const int tid = (wr * 4 + wc) * 64 + fq * 16 + fr;
            if (tid < 256) { const f32x4 v = *(const PG8_LAS f32x4*)(xs + tid * 4); ssq[(size_t)(u.pm * BM + tid) * 4 + u.pn] = (v[0] + v[1]) + (v[2] + v[3]); }
        }
    }
};

struct EpiSwiGLU {
    static constexpr bool PERM = true, AFTER_DRAIN = false, PF = true, A_TILED = false;
    bf16_t* H; int ldh; const float* ssq; PG8_LAS unsigned char* lds;
    __device__ __forceinline__ void prefetch(const Unit& u, int wid, int lane) const { pf_issue(ssq, nullptr, u, lds, wid, lane); }
    __device__ __forceinline__ void operator()(const f32x4 (&acc)[2][2][4][2], const Unit& u, int wr, int wc, int fr, int fq) const {
        const int row0 = u.pm * BM + wr * 64 + fr, hcol = u.pn * HALF + wc * 32 + 8 * fq;
        float rsv[8];
#pragma unroll
        for (int q = 0; q < 8; ++q) rsv[q] = row_ss_lds(lds, wr * 64 + fr + (q >> 2) * HALF + (q & 3) * 16);
#pragma unroll
        for (int q = 0; q < 8; ++q) rsv[q] = __builtin_amdgcn_rsqf(rsv[q] * (1.0f / 1024.0f) + RMS_EPS);
#pragma unroll
        for (int ai = 0; ai < 2; ++ai)
#pragma unroll
            for (int m = 0; m < 4; ++m) {
                const int row = row0 + ai * HALF + m * 16;
                const float rs = rsv[ai * 4 + m];
                const f32x2 c1 = {-rs * LOG2E, -rs * LOG2E}, rs2 = {rs * rs, rs * rs}, one = {1.0f, 1.0f};
                unsigned wv[4];
#pragma unroll
                for (int n = 0; n < 2; ++n)
#pragma unroll
                    for (int p = 0; p < 2; ++p) {
                        const f32x2 av = {acc[ai][0][m][n][2 * p], acc[ai][0][m][n][2 * p + 1]}, bv = {acc[ai][1][m][n][2 * p], acc[ai][1][m][n][2 * p + 1]};
                        const f32x2 t = av * c1;
                        f32x2 e; e[0] = __builtin_amdgcn_exp2f(t[0]); e[1] = __builtin_amdgcn_exp2f(t[1]);
                        const f32x2 d = e + one;
                        f32x2 r; r[0] = __builtin_amdgcn_rcpf(d[0]); r[1] = __builtin_amdgcn_rcpf(d[1]);
                        const f32x2 hv = (av * bv) * (r * rs2);
                        wv[2 * n + p] = cvt_pk_bf16(hv[0], hv[1]);
                    }
                u32x4 w; w.x = wv[0]; w.y = wv[1]; w.z = wv[2]; w.w = wv[3];
                store16_wt(H + ((size_t)(u.pm * (ldh / 64) + (hcol >> 6)) * BM + (size_t)(row - u.pm * BM)) * 64 + (hcol & 63), w);
            }
    }
};


struct EpiNull {
    static constexpr bool PERM = true, AFTER_DRAIN = false, PF = false, A_TILED = false;
    __device__ __forceinline__ void operator()(const f32x4 (&acc)[2][2][4][2], const Unit& u, int wr, int wc, int fr, int fq) const {
#pragma unroll
        for (int ai = 0; ai < 2; ++ai)
#pragma unroll
            for (int bj = 0; bj < 2; ++bj)
#pragma unroll
                for (int m = 0; m < 4; ++m)
#pragma unroll
                    for (int n = 0; n < 2; ++n) asm volatile("" :: "v"(acc[ai][bj][m][n]));
    }
};

template <class Epi, class Sched, bool ALIGN_EPI = false, bool SP2 = false>
__device__ __forceinline__ void gemm_phase(PG8_LAS unsigned char* lds, const Gemm g, const Sched& S, const Epi& E) {
    const int tid = threadIdx.x, wid = __builtin_amdgcn_readfirstlane(tid >> 6), lane = tid & 63, wr = wid >> 2, wc = wid & 3, fr = lane & 15, fq = lane >> 4;
    const int K = g.K, nt = K / BK;
    unsigned voffA[2], voffB[2];
#pragma unroll
    for (int i = 0; i < 2; ++i) { int R, C; stage_rc(tid * 16 + i * 8192, R, C); const int Rb = Epi::PERM ? ((R & ~31) + perm32(R & 31)) : R;
        voffA[i] = (unsigned)(R * (Epi::A_TILED ? BK : K) + C) * 2u; voffB[i] = (unsigned)(Rb * K + C) * 2u; }
    const size_t kstep = (size_t)(BK * 2);
    const size_t hstep = (size_t)HALF * K * 2;
    const size_t tstep = 2 * hstep;
    const size_t kstepA = Epi::A_TILED ? (size_t)(BM * BK * 2) : kstep, hstepA = Epi::A_TILED ? (size_t)(HALF * BK * 2) : hstep, tstepA = Epi::A_TILED ? (size_t)nt * (BM * BK * 2) : tstep;
    const unsigned ldsw = (unsigned)wid * 1024u;
    const int aoff = lds_byte(wr * 64 + fr, fq * 8), boff = lds_byte(wc * 32 + fr, fq * 8);
#define PG8_SA(b, h) (((b) * 2 + (h)) * HTB)
#define PG8_SB(b, h) ((4 + (b) * 2 + (h)) * HTB)
#define PG8_STAGE(bufoff, gbase, voff) do { _Pragma("unroll") for (int _i = 0; _i < 2; ++_i) \
        __builtin_amdgcn_global_load_lds((const unsigned*)((const char*)(gbase) + (voff)[_i]), (PG8_LAS unsigned*)(lds + (bufoff) + ldsw + _i * 8192), 16, 0, 0); } while (0)
#define PG8_LDA(dst, b, h) do { _Pragma("unroll") for (int m = 0; m < 4; ++m) _Pragma("unroll") for (int k = 0; k < 2; ++k) dst[m][k] = *(const PG8_LAS bf16x8*)(lds + PG8_SA(b, h) + aoff + m * 2048 + k * 1024); } while (0)
#define PG8_LDB(dst, b, h) do { _Pragma("unroll") for (int n = 0; n < 2; ++n) _Pragma("unroll") for (int k = 0; k < 2; ++k) dst[n][k] = *(const PG8_LAS bf16x8*)(lds + PG8_SB(b, h) + boff + n * 2048 + k * 1024); } while (0)
#define PG8_MMA(ai, bj, At, Bt) do { __builtin_amdgcn_s_setprio(1); _Pragma("unroll") for (int m = 0; m < 4; ++m) _Pragma("unroll") for (int n = 0; n < 2; ++n) _Pragma("unroll") for (int k = 0; k < 2; ++k) \
        acc[ai][bj][m][n] = __builtin_amdgcn_mfma_f32_16x16x32_bf16(Bt[n][k], At[m][k], acc[ai][bj][m][n], 0, 0, 0); __builtin_amdgcn_s_setprio(0); } while (0)
#define PG8_WAIT_V(n) asm volatile("s_waitcnt vmcnt(" #n ")" ::: "memory")
#define PG8_WAIT_L(n) asm volatile("s_waitcnt lgkmcnt(" #n ")" ::: "memory")
#define PG8_BAR __builtin_amdgcn_s_barrier()
#define PG8_SCHED __builtin_amdgcn_sched_barrier(0)
    Unit cur, nxt; int ui = 0;
    if (!S.next(0, cur)) return;
    f32x4 acc[2][2][4][2];
#pragma unroll
    for (int a = 0; a < 2; ++a)
#pragma unroll
        for (int b = 0; b < 2; ++b)
#pragma unroll
            for (int m = 0; m < 4; ++m)
#pragma unroll
                for (int n = 0; n < 2; ++n) acc[a][b][m][n] = (f32x4){0.f, 0.f, 0.f, 0.f};
    bf16x8 At[4][2], B0[2][2], B1[2][2];
    const char* cA = (const char*)g.A + (size_t)cur.pm * tstepA; const char* cB = (const char*)g.Bt + (size_t)cur.pn * tstep;
    S.a_ready(cur);
    if constexpr (SP2) {
        PG8_STAGE(PG8_SB(0, 0), cB, voffB); PG8_STAGE(PG8_SB(0, 1), cB + hstep, voffB); PG8_STAGE(PG8_SA(0, 0), cA, voffA); PG8_STAGE(PG8_SA(0, 1), cA + hstepA, voffA);
        if (wr == 1) PG8_BAR;
        PG8_WAIT_V(2); PG8_BAR;
        PG8_STAGE(PG8_SB(1, 0), cB + kstep, voffB); PG8_STAGE(PG8_SA(1, 0), cA + kstepA, voffA); PG8_STAGE(PG8_SB(1, 1), cB + hstep + kstep, voffB);
        PG8_WAIT_V(6); PG8_BAR;
    } else {
        PG8_STAGE(PG8_SB(0, 0), cB, voffB); PG8_STAGE(PG8_SA(0, 0), cA, voffA); PG8_STAGE(PG8_SB(0, 1), cB + hstep, voffB); PG8_STAGE(PG8_SA(0, 1), cA + hstepA, voffA);
        if (wr == 1) PG8_BAR;
        PG8_WAIT_V(4); PG8_BAR;
        PG8_STAGE(PG8_SB(1, 0), cB + kstep, voffB); PG8_STAGE(PG8_SA(1, 0), cA + kstepA, voffA); PG8_STAGE(PG8_SB(1, 1), cB + hstep + kstep, voffB);
        PG8_WAIT_V(6); PG8_BAR;
    }
    for (;;) {
        const bool has_next = S.next(ui + 1, nxt);
        const char* nA = has_next ? (const char*)g.A + (size_t)nxt.pm * tstepA : cA; const char* nB = has_next ? (const char*)g.Bt + (size_t)nxt.pn * tstep : cB;
        for (int t = 0; t < nt; t += 2) {
            const bool last = (t == nt - 2);
            const char* a1 = cA + (size_t)(t + 1) * kstepA;
            const char* a2 = last ? nA : cA + (size_t)(t + 2) * kstepA; const char* b2 = last ? nB : cB + (size_t)(t + 2) * kstep;
            const char* a3 = a2 + kstepA; const char* b3 = b2 + kstep;
            if (last && has_next) S.a_ready(nxt);
            if constexpr (SP2) {
            PG8_LDB(B0, 0, 0); PG8_LDB(B1, 0, 1); PG8_SCHED; PG8_LDA(At, 0, 0); PG8_STAGE(PG8_SA(1, 1), a1 + hstepA, voffA);
            bool pf = false; if constexpr (Epi::PF) pf = (t == nt - 4);
            if (pf) { if constexpr (Epi::PF) E.prefetch(cur, wid, lane); PG8_WAIT_V(9); } else { PG8_WAIT_V(8); }
            PG8_WAIT_L(0); PG8_BAR; PG8_MMA(0, 0, At, B0); PG8_MMA(0, 1, At, B1); PG8_BAR; PG8_SCHED;
            PG8_LDA(At, 0, 1); PG8_STAGE(PG8_SB(0, 0), b2, voffB); PG8_STAGE(PG8_SB(0, 1), b2 + hstep, voffB); PG8_STAGE(PG8_SA(0, 0), a2, voffA);
            if (pf) { PG8_WAIT_V(9); } else { PG8_WAIT_V(8); }
            PG8_WAIT_L(0); PG8_BAR; PG8_MMA(1, 0, At, B0); PG8_MMA(1, 1, At, B1); PG8_BAR; PG8_SCHED;
            PG8_LDB(B0, 1, 0); PG8_LDB(B1, 1, 1); PG8_SCHED; PG8_LDA(At, 1, 0); PG8_STAGE(PG8_SA(0, 1), a2 + hstepA, voffA);
            PG8_WAIT_V(8); PG8_WAIT_L(0); PG8_BAR; PG8_MMA(0, 0, At, B0); PG8_MMA(0, 1, At, B1); PG8_BAR; PG8_SCHED;
            PG8_LDA(At, 1, 1); PG8_STAGE(PG8_SB(1, 0), b3, voffB); PG8_STAGE(PG8_SB(1, 1), b3 + hstep, voffB); PG8_STAGE(PG8_SA(1, 0), a3, voffA);
            PG8_WAIT_V(8); PG8_WAIT_L(0); PG8_BAR; PG8_MMA(1, 0, At, B0); PG8_MMA(1, 1, At, B1); PG8_BAR; PG8_SCHED;
            } else {
            PG8_LDB(B0, 0, 0); PG8_SCHED; PG8_LDA(At, 0, 0); PG8_STAGE(PG8_SA(1, 1), a1 + hstepA, voffA);
            PG8_WAIT_L(8); PG8_BAR; PG8_WAIT_L(0); PG8_MMA(0, 0, At, B0); PG8_BAR; PG8_SCHED;
            PG8_LDB(B1, 0, 1); PG8_STAGE(PG8_SB(0, 0), b2, voffB);
            PG8_BAR; PG8_WAIT_L(0); PG8_MMA(0, 1, At, B1); PG8_BAR;
            PG8_LDA(At, 0, 1); PG8_STAGE(PG8_SA(0, 0), a2, voffA);
            PG8_BAR; PG8_WAIT_L(0); PG8_MMA(1, 0, At, B0); PG8_BAR; PG8_SCHED;
            PG8_STAGE(PG8_SB(0, 1), b2 + hstep, voffB);
            PG8_WAIT_V(6); PG8_BAR; PG8_MMA(1, 1, At, B1); PG8_BAR;
            PG8_LDB(B0, 1, 0); PG8_SCHED; PG8_LDA(At, 1, 0); PG8_STAGE(PG8_SA(0, 1), a2 + hstepA, voffA);
            PG8_WAIT_L(8); PG8_BAR; PG8_WAIT_L(0); PG8_MMA(0, 0, At, B0); PG8_BAR; PG8_SCHED;
            PG8_LDB(B1, 1, 1); PG8_STAGE(PG8_SB(1, 0), b3, voffB);
            PG8_BAR; PG8_WAIT_L(0); PG8_MMA(0, 1, At, B1); PG8_BAR;
            PG8_LDA(At, 1, 1); PG8_STAGE(PG8_SA(1, 0), a3, voffA);
            PG8_BAR; PG8_WAIT_L(0); PG8_MMA(1, 0, At, B0); PG8_BAR; PG8_SCHED;
            PG8_STAGE(PG8_SB(1, 1), b3 + hstep, voffB);
            PG8_WAIT_V(6); PG8_BAR; PG8_MMA(1, 1, At, B1); PG8_BAR;
            }
        }
        if constexpr (ALIGN_EPI) { if (wr == 0) PG8_BAR; }
        if constexpr (!Epi::AFTER_DRAIN) { E(acc, cur, wr, wc, fr, fq); S.done(cur); }
        if (!has_next) break;
#pragma unroll
        for (int a = 0; a < 2; ++a)
#pragma unroll
            for (int b = 0; b < 2; ++b)
#pragma unroll
                for (int m = 0; m < 4; ++m)
#pragma unroll
                    for (int n = 0; n < 2; ++n) acc[a][b][m][n] = (f32x4){0.f, 0.f, 0.f, 0.f};
        cur = nxt; cA = nA; cB = nB; ++ui;
        if constexpr (ALIGN_EPI) { if (wr == 1) PG8_BAR; }
    }
    PG8_WAIT_V(0);
    if constexpr (!ALIGN_EPI) { if (wr == 0) PG8_BAR; }
    PG8_BAR;
    if constexpr (Epi::AFTER_DRAIN) { E.fused(acc, cur, wr, wc, fr, fq, lds, wid, lane); S.done(cur); }
#undef PG8_SA
#undef PG8_SB
#undef PG8_STAGE
#undef PG8_LDA
#undef PG8_LDB
#undef PG8_MMA
#undef PG8_WAIT_V
#undef PG8_WAIT_L
#undef PG8_BAR
#undef PG8_SCHED
}
}

#define GAS __attribute__((address_space(1)))
#define LAS __attribute__((address_space(3)))
typedef unsigned short bf16;
typedef unsigned v4u __attribute__((ext_vector_type(4)));
typedef float f32x4 __attribute__((ext_vector_type(4)));
typedef short bf16x8 __attribute__((ext_vector_type(8)));
typedef GAS unsigned gu32;
typedef GAS unsigned long long gu64;
#define RLX_AGENT __ATOMIC_RELAXED, __HIP_MEMORY_SCOPE_AGENT
#define LDS_WAIT() asm volatile("s_waitcnt lgkmcnt(0)" ::: "memory")
#define VM_WAIT() asm volatile("s_waitcnt vmcnt(0)" ::: "memory")
__device__ __forceinline__ unsigned long long rt() { return __builtin_amdgcn_s_memrealtime(); }
__device__ __forceinline__ unsigned f2bf(float f) { unsigned u = __builtin_bit_cast(unsigned, f); return (u + 0x7fffu + ((u >> 16) & 1u)) >> 16; }
__device__ __forceinline__ unsigned pk2(float lo, float hi) { return f2bf(lo) | (f2bf(hi) << 16); }

#define XB_TMO      128
#define XB_XCNT(j)  (256  + 64 * (j))
#define XB_XSUB(j)  (1280 + 64 * (j))
#define XB_XGEN(j)  (2304 + 64 * (j))
#define XB_TOP      3328
#define XB_TOPGEN   3392
#define XCD_BAR_WORDS 3456
#define XB_SPIN_CAP (1u << 18)

__device__ __forceinline__ unsigned xb_ld(unsigned* p)              { return __hip_atomic_load(p, __ATOMIC_RELAXED, __HIP_MEMORY_SCOPE_AGENT); }
__device__ __forceinline__ unsigned xb_add(unsigned* p, unsigned v) { return __hip_atomic_fetch_add(p, v, __ATOMIC_RELAXED, __HIP_MEMORY_SCOPE_AGENT); }
__device__ __forceinline__ unsigned xb_xcc_id() { return (unsigned)__builtin_amdgcn_s_getreg((3 << 11) | 20) & 0xFu; }
#define XB_SPIN(cond, bar) do { unsigned _sp = 0; while (cond) { __builtin_amdgcn_s_sleep(1); \
    if ((++_sp & 255u) == 0u) { if (xb_ld(&(bar)[XB_TMO])) break; if (_sp > XB_SPIN_CAP) { atomicAdd(&(bar)[XB_TMO], 1u); break; } } } } while (0)

struct XcdBarrier {
    unsigned* bar; unsigned x;
    volatile LAS unsigned* st;
};

__device__ __forceinline__ XcdBarrier xcd_barrier_post(unsigned* bar, volatile LAS unsigned* st) {
    XcdBarrier b; b.bar = bar; b.x = xb_xcc_id(); b.st = st;
    if (threadIdx.x == 0) (void)xb_add(&bar[XB_XCNT(b.x)], 1u);
    return b;
}
__device__ __forceinline__ void xcd_barrier_complete(unsigned* bar, unsigned x, unsigned& nloc, unsigned& nx) {
    const unsigned G = gridDim.x * gridDim.y * gridDim.z;
    unsigned sum, cnt, mine, sp = 0u;
    for (;;) {
        sum = 0u; cnt = 0u; mine = 0u;
#pragma unroll
        for (unsigned j = 0; j < 16; ++j) { const unsigned c = xb_ld(&bar[XB_XCNT(j)]); sum += c; cnt += (c > 0u) ? 1u : 0u; mine = (j == x) ? c : mine; }
        if (sum == G) break;
        __builtin_amdgcn_s_sleep(1);
        if ((++sp & 255u) == 0u) { if (xb_ld(&bar[XB_TMO])) break; if (sp > XB_SPIN_CAP) { atomicAdd(&bar[XB_TMO], 1u); break; } }
    }
    nloc = mine > 0u ? mine : 1u; nx = cnt > 0u ? cnt : 1u;
}

__device__ __forceinline__ void xcd_barrier(const XcdBarrier& b) {
    asm volatile("s_waitcnt vmcnt(0)" ::: "memory");
    __syncthreads();
    if (threadIdx.x == 0) {
        unsigned* bar = b.bar;
        __builtin_amdgcn_s_waitcnt(0);
        unsigned nloc = b.st[0], nx = b.st[1];
        if (nloc == 0u) { xcd_barrier_complete(bar, b.x, nloc, nx); b.st[0] = nloc; b.st[1] = nx; }
        const unsigned old = xb_add(&bar[XB_XSUB(b.x)], 1u);
        const unsigned gen = old / nloc;
        if (old + 1u == (gen + 1u) * nloc) {
            __builtin_amdgcn_fence(__ATOMIC_RELEASE, "agent");
            asm volatile("s_waitcnt vmcnt(0)" ::: "memory");
            const unsigned og = xb_add(&bar[XB_TOP], 1u);
            const unsigned tg = og / nx;
            if (og + 1u == (tg + 1u) * nx) xb_add(&bar[XB_TOPGEN], 1u);
            else XB_SPIN(xb_ld(&bar[XB_TOPGEN]) == tg, bar);
            __builtin_amdgcn_fence(__ATOMIC_ACQUIRE, "agent");
            xb_add(&bar[XB_XGEN(b.x)], 1u);
            asm volatile("s_waitcnt vmcnt(0)" ::: "memory");
        } else {
            XB_SPIN(xb_ld(&bar[XB_XGEN(b.x)]) == gen, bar);
            __builtin_amdgcn_fence(__ATOMIC_ACQUIRE, "agent");
            asm volatile("s_waitcnt vmcnt(0)" ::: "memory");
        }
    }
    __syncthreads();
}

constexpr int NWAVES = 8;
constexpr int NB = 16, SEQ = 2048, DM = 1024, M = NB * SEQ;
constexpr int EVW = 3080, N_IN = 3072, FFH = 2816, N_UP = 2 * FFH, N_QKV = 1536;
constexpr float LOG2E_F = 1.4426950408889634f;
constexpr size_t MiB = 1u << 20;
constexpr size_t WS_CTL = 0, CTL_ZERO_BYTES = 1 * MiB;
constexpr size_t WS_SSQ = 186 * MiB;
constexpr size_t WS_GT = 1 * MiB + 768 * 1024;
constexpr size_t WS_LF = 2 * MiB;
constexpr size_t WS_C2 = 3 * MiB;
constexpr size_t WS_W = 4 * MiB;
constexpr size_t WO_IN = 0, WO_EO = WO_IN + (size_t)N_IN * DM * 2, WO_UP0 = WO_EO + (size_t)DM * DM * 2, WO_DN0 = WO_UP0 + (size_t)N_UP * DM * 2,
                 WO_QKV = WO_DN0 + (size_t)DM * FFH * 2, WO_OO = WO_QKV + (size_t)N_QKV * DM * 2, WO_UP1 = WO_OO + (size_t)DM * DM * 2, WO_DN1 = WO_UP1 + (size_t)N_UP * DM * 2,
                 WO_END = WO_DN1 + (size_t)DM * FFH * 2;
static_assert(WO_END <= 46 * MiB, "weights");
constexpr size_t WS_XB = 50 * MiB;
constexpr size_t WS_R1 = 178 * MiB;
constexpr size_t WS_CKREC = 182 * MiB;
constexpr size_t WS_BIG = 306 * MiB;
constexpr size_t WS_MIX = 114 * MiB;
constexpr size_t WS_END = 498 * MiB;
constexpr int CW_BAR = 4096;
constexpr int CW_FOXQ = 24576;

constexpr int RING_OFF = 0, RING_BYTES = 131072;
constexpr int LDSCTL_OFF = 139264, MISC_OFF = LDSCTL_OFF + 320;
constexpr int LDS_BYTES = 147456;

__device__ const unsigned char kBucket[128] = {
    0, 1, 2, 3, 4, 5, 6, 7, 8, 9, 10, 11, 12, 13, 14, 15, 16, 16, 16, 17, 17, 18, 18, 18, 19, 19, 19, 20, 20, 20, 20, 21,
    21, 21, 21, 22, 22, 22, 22, 22, 23, 23, 23, 23, 23, 23, 24, 24, 24, 24, 24, 24, 25, 25, 25, 25, 25, 25, 25, 26, 26, 26, 26, 26,
    26, 26, 26, 27, 27, 27, 27, 27, 27, 27, 27, 27, 27, 28, 28, 28, 28, 28, 28, 28, 28, 28, 28, 29, 29, 29, 29, 29, 29, 29, 29, 29,
    29, 29, 29, 30, 30, 30, 30, 30, 30, 30, 30, 30, 30, 30, 30, 30, 30, 31, 31, 31, 31, 31, 31, 31, 31, 31, 31, 31, 31, 31, 31, 31};

struct Args {
    const float* in[25]; float* out; unsigned char* ws; int ph_lo, ph_hi, use_bar, rep_mask;
};

struct Frame {
    LAS unsigned char* lds;
    volatile LAS unsigned* MISC;
    gu32* ctl;
    int tid, lane, wave, vcu, G;
};

__device__ __forceinline__ float wave_sum(float v) {
#pragma unroll
    for (int o = 1; o < 64; o <<= 1) v += __shfl_xor(v, o);
    return v;
}
__device__ __forceinline__ float bf2f(bf16 v) { return __builtin_bit_cast(float, (unsigned)v << 16); }

enum { MAP_PLAIN = 0, MAP_IN = 1, MAP_HEADPERM = 2, MAP_GATE = 3, MAP_UP = 4 };
__device__ __forceinline__ int dest_row(int kind, int col) {
    if (kind == MAP_PLAIN) return col;
    if (kind == MAP_GATE) return 256 * (col >> 7) + (col & 127);
    if (kind == MAP_UP) return 256 * (col >> 7) + 128 + (col & 127);
    int c = col;
    if (kind == MAP_IN) { if (col >= 1536 && col < 1544) return -1; if (col >= 1544) c = col - 8; }
    const int t = c & ~255, w = c & 255, g = w >> 6, b = (w >> 5) & 1, j = w & 31;
    return t + 128 * b + 32 * g + j;
}
struct WJob { const float* W; const float* gain; bf16* WT; int K, N, kind, start, pad; };
struct TrRegs { f32x4 r[8]; float g[8]; int k0, n0, job; };
constexpr int NJOBS = 10;
__device__ __forceinline__ void tr_load(TrRegs& R, const LAS WJob* jobs, int it, int lane) {
    int jb = 0;
#pragma unroll
    for (int q = 1; q < NJOBS; ++q) if (it >= jobs[q].start) jb = q;
    const LAS WJob& J = jobs[jb];
    const int local = it - J.start, N = J.N, nblk = (N + 31) >> 5, kb = local / nblk, nb = local - kb * nblk;
    R.k0 = 64 * kb; R.n0 = 32 * nb; R.job = jb;
    const float* W = J.W; const float* gain = J.gain;
    const int cc = R.n0 + 4 * (lane & 7);
#pragma unroll
    for (int i = 0; i < 8; ++i) { const int kk = R.k0 + (lane >> 3) + 8 * i;
        R.r[i] = (f32x4){0.f, 0.f, 0.f, 0.f}; if (cc < N) R.r[i] = *(const GAS f32x4*)(W + (size_t)kk * N + cc);
        R.g[i] = 1.0f; if (gain) R.g[i] = gain[kk]; }
}
__device__ __forceinline__ void tr_store(const TrRegs& R, const LAS WJob* jobs, LAS float* scr, int lane) {
    const LAS WJob& J = jobs[R.job];
    const int N = J.N, K = J.K, kind = J.kind; bf16* WT = J.WT;
#pragma unroll
    for (int i = 0; i < 8; ++i) { LAS float* s = scr + ((lane >> 3) + 8 * i) * 33 + 4 * (lane & 7); const float g = R.g[i];
        s[0] = R.r[i].x * g; s[1] = R.r[i].y * g; s[2] = R.r[i].z * g; s[3] = R.r[i].w * g; }
    LDS_WAIT(); asm volatile("" ::: "memory");
    const int c = lane & 7;
#pragma unroll
    for (int j = 0; j < 4; ++j) { const int n = (lane >> 3) + 8 * j; const LAS float* s = scr + (8 * c) * 33 + n;
        v4u o; o.x = pk2(s[0 * 33], s[1 * 33]); o.y = pk2(s[2 * 33], s[3 * 33]); o.z = pk2(s[4 * 33], s[5 * 33]); o.w = pk2(s[6 * 33], s[7 * 33]);
        const int col = R.n0 + n; const int dr = (col < N) ? dest_row(kind, col) : -1;
        if (dr >= 0) *(GAS v4u*)(WT + (size_t)dr * K + R.k0 + 8 * c) = o; }
    LDS_WAIT(); asm volatile("" ::: "memory");
}

struct XRegs { f32x4 v[4]; };
__device__ __forceinline__ void x_load(XRegs& X, const float* x, int m, int lane) {
    const GAS f32x4* xr = (const GAS f32x4*)(x + (size_t)m * DM) + lane;
#pragma unroll
    for (int j = 0; j < 4; ++j) X.v[j] = __builtin_nontemporal_load(xr + 64 * j);
}
__device__ __forceinline__ void x_row(const XRegs& X, int m, const LAS float* wfT, float* ssq, float* lf, bf16* xb, const float* bfg, int lane) {
    float s = 0.f;
#pragma unroll
    for (int j = 0; j < 4; ++j) s += (X.v[j].x * X.v[j].x + X.v[j].y * X.v[j].y) + (X.v[j].z * X.v[j].z + X.v[j].w * X.v[j].w);
    float ff[8];
#pragma unroll
    for (int h = 0; h < 8; ++h) { float acc = 0.f;
#pragma unroll
        for (int j = 0; j < 4; ++j) { const f32x4 w = *(const LAS f32x4*)(wfT + h * DM + 256 * j + 4 * lane); acc += (X.v[j].x * w.x + X.v[j].y * w.y) + (X.v[j].z * w.z + X.v[j].w * w.w); }
        ff[h] = acc; }
    GAS unsigned long long* o8 = (GAS unsigned long long*)(xb + (size_t)m * DM) + lane;
#pragma unroll
    for (int j = 0; j < 4; ++j) o8[64 * j] = (unsigned long long)pk2(X.v[j].x, X.v[j].y) | ((unsigned long long)pk2(X.v[j].z, X.v[j].w) << 32);
    const bool b5 = lane & 32, b4 = lane & 16, b3 = lane & 8;
    float t4[4];
#pragma unroll
    for (int i = 0; i < 4; ++i) { const float keep = b5 ? ff[i + 4] : ff[i], give = b5 ? ff[i] : ff[i + 4]; t4[i] = keep + __shfl_xor(give, 32); }
    float t2[2];
#pragma unroll
    for (int i = 0; i < 2; ++i) { const float keep = b4 ? t4[i + 2] : t4[i], give = b4 ? t4[i] : t4[i + 2]; t2[i] = keep + __shfl_xor(give, 16); }
    float t1;
    { const float keep = b3 ? t2[1] : t2[0], give = b3 ? t2[0] : t2[1]; t1 = keep + __shfl_xor(give, 8); }
    t1 += __shfl_xor(t1, 4); t1 += __shfl_xor(t1, 2); t1 += __shfl_xor(t1, 1);
    s = wave_sum(s);
    const float rs = __builtin_amdgcn_rsqf(s * (1.0f / DM) + 1e-6f);
    if ((lane & 7) == 0) { const int h = lane >> 3; const float z = t1 * rs + bfg[h]; lf[(size_t)m * 8 + h] = fminf(z, 0.f) - log1pf(expf(-fabsf(z))); }
    if (lane == 1) { *(f32x4*)(ssq + (size_t)m * 4) = (f32x4){s, 0.f, 0.f, 0.f}; }
}

__device__ __forceinline__ void p0_prologue(Frame& F, const Args& a) {
    unsigned char* ws = a.ws;
    bf16* wb = (bf16*)(ws + WS_W);
    LAS float* scr = (LAS float*)(F.lds + RING_OFF + F.wave * 16384);
    LAS WJob* jobs = (LAS WJob*)(F.lds + LDSCTL_OFF + 1024);
    const int gw = F.vcu * NWAVES + F.wave, NGW = F.G * NWAVES;
    int total;
    {
        int st = 0;
#define SETJOB(q, Wp, Kk, Nn, gainp, WTp, kindv) { if (F.tid == 0) { jobs[q].W = (Wp); jobs[q].gain = (gainp); jobs[q].WT = (WTp); jobs[q].K = (Kk); jobs[q].N = (Nn); jobs[q].kind = (kindv); jobs[q].start = st; jobs[q].pad = 0; } \
            st += ((Kk) / 64) * (((Nn) + 31) / 32); }
        SETJOB(0, a.in[3], DM, EVW, a.in[2], (bf16*)((char*)wb + WO_IN), MAP_IN)
        SETJOB(1, a.in[14], DM, DM, (const float*)nullptr, (bf16*)((char*)wb + WO_EO), MAP_PLAIN)
        SETJOB(2, a.in[22], DM, FFH, a.in[21], (bf16*)((char*)wb + WO_UP0), MAP_GATE)
        SETJOB(3, a.in[23], DM, FFH, a.in[21], (bf16*)((char*)wb + WO_UP0), MAP_UP)
        SETJOB(4, a.in[24], FFH, DM, (const float*)nullptr, (bf16*)((char*)wb + WO_DN0), MAP_PLAIN)
        SETJOB(5, a.in[16], DM, N_QKV, a.in[15], (bf16*)((char*)wb + WO_QKV), MAP_HEADPERM)
        SETJOB(6, a.in[20], DM, DM, (const float*)nullptr, (bf16*)((char*)wb + WO_OO), MAP_PLAIN)
        SETJOB(7, a.in[22] + (size_t)DM * FFH, DM, FFH, a.in[21] + DM, (bf16*)((char*)wb + WO_UP1), MAP_GATE)
        SETJOB(8, a.in[23] + (size_t)DM * FFH, DM, FFH, a.in[21] + DM, (bf16*)((char*)wb + WO_UP1), MAP_UP)
        SETJOB(9, a.in[24] + (size_t)FFH * DM, FFH, DM, (const float*)nullptr, (bf16*)((char*)wb + WO_DN1), MAP_PLAIN)
#undef SETJOB
        total = st;
    }
    __syncthreads();
    {
        TrRegs A, B;
        int it = gw;
        if (it < total) tr_load(A, jobs, it, F.lane);
        while (it < total) {
            const int n1 = it + NGW;
            if (n1 < total) tr_load(B, jobs, n1, F.lane);
            tr_store(A, jobs, scr, F.lane);
            if (n1 >= total) break;
            const int n2 = n1 + NGW;
            if (n2 < total) tr_load(A, jobs, n2, F.lane);
            tr_store(B, jobs, scr, F.lane);
            it = n2;
        }
    }
    if (F.vcu == 0) {
        float* gt = (float*)(ws + WS_GT);
        for (int t = F.tid; t < 18 * 64; t += NWAVES * 64) {
            const int tile = t >> 6, e = t & 63; float val;
            if (tile < 12) { const int tt = tile >> 1, kind = tt % 3, grp = tt / 3;
                const float q0 = a.in[5][e], k0 = a.in[6][e], q1 = a.in[7][e], k1 = a.in[8][e];
                const float qv = grp == 0 ? q0 : q1, kv = grp == 0 ? k0 : k1;
                val = kind == 0 ? qv * (0.125f * LOG2E_F) : (kind == 1 ? kv : 1.0f); }
            else { const int pn = tile - 12; const float qv = a.in[17][e], kv = a.in[18][e]; val = pn < 4 ? qv * (0.125f * LOG2E_F) : (pn == 4 ? kv : 1.0f); }
            gt[t] = val;
        }
    }
    __syncthreads();
    LAS float* wfT = (LAS float*)(F.lds + RING_OFF);
    for (int i = F.tid; i < 8 * DM; i += NWAVES * 64) { const int k = i >> 3, h = i & 7; wfT[h * DM + k] = a.in[3][(size_t)k * EVW + 1536 + h] * a.in[2][k]; }
    __syncthreads();
    {
        float* ssq = (float*)(ws + WS_SSQ); float* lf = (float*)(ws + WS_LF); bf16* xb = (bf16*)(ws + WS_XB);
        const float* x = a.in[0]; const float* bfg = a.in[4];
        XRegs A, B;
        const bool aff = (F.G == 256);
        const int lw = (F.vcu & 31) * NWAVES + F.wave, rbase = (F.vcu >> 5) * 4096;
        const int nk = aff ? 16 : (gw < M ? (M - gw + NGW - 1) / NGW : 0);
#define X_ROWOF(k) (aff ? (rbase + (15 - (k)) * 256 + lw) : (gw + (k) * NGW))
        int k = 0;
        if (k < nk) x_load(A, x, X_ROWOF(k), F.lane);
        while (k < nk) {
            if (k + 1 < nk) x_load(B, x, X_ROWOF(k + 1), F.lane);
            x_row(A, X_ROWOF(k), wfT, ssq, lf, xb, bfg, F.lane);
            if (k + 1 >= nk) break;
            if (k + 2 < nk) x_load(A, x, X_ROWOF(k + 2), F.lane);
            x_row(B, X_ROWOF(k + 1), wfT, ssq, lf, xb, bfg, F.lane);
            k += 2;
        }
#undef X_ROWOF
    }
}

__device__ __forceinline__ void cumsum_phase(Frame& F, const Args& a) {
    if (F.vcu >= NB * 8) return;
    const int b = F.vcu >> 3, h = F.vcu & 7;
    const float* lf = (const float*)(a.ws + WS_LF); float* c2 = (float*)(a.ws + WS_C2) + (size_t)F.vcu * SEQ;
    LAS float* wt = (LAS float*)(F.lds + RING_OFF);
    float v[4]; float run = 0.f;
#pragma unroll
    for (int i = 0; i < 4; ++i) { run += lf[((size_t)b * SEQ + 4 * F.tid + i) * 8 + h]; v[i] = run; }
    float inc = run;
#pragma unroll
    for (int o = 1; o < 64; o <<= 1) { const float t = __shfl_up(inc, o); if (F.lane >= o) inc += t; }
    if (F.lane == 63) wt[F.wave] = inc;
    __syncthreads();
    float base = 0.f;
    for (int w = 0; w < F.wave; ++w) base += wt[w];
    const float off = base + inc - run;
    f32x4 o; o.x = (v[0] + off) * LOG2E_F; o.y = (v[1] + off) * LOG2E_F; o.z = (v[2] + off) * LOG2E_F; o.w = (v[3] + off) * LOG2E_F;
    *(f32x4*)(c2 + 4 * F.tid) = o;
    {
        v4u* rec = (v4u*)(a.ws + WS_CKREC) + (size_t)F.vcu * SEQ + 4 * F.tid;
        const float vals[4] = {o.x, o.y, o.z, o.w};
#pragma unroll
        for (int i = 0; i < 4; ++i) { const float nv = -vals[i]; const unsigned hi16 = f2bf(nv); const float hif = __builtin_bit_cast(float, hi16 << 16); const unsigned lo16 = f2bf(nv - hif);
            v4u r; r.x = hi16 | (lo16 << 16); r.y = 0u; r.z = 0u; r.w = 0u; rec[i] = r; }
    }
    __syncthreads();
}

namespace att {
typedef short bf16x8 __attribute__((ext_vector_type(8)));
typedef short s16x4 __attribute__((ext_vector_type(4)));
typedef short v4i16_t __attribute__((ext_vector_type(4)));
typedef float f32x16 __attribute__((ext_vector_type(16)));
typedef float f32x4v __attribute__((ext_vector_type(4)));
typedef unsigned u32x4v __attribute__((ext_vector_type(4)));
typedef int i32x4v __attribute__((ext_vector_type(4)));
typedef __attribute__((address_space(3))) unsigned char* lptr;
typedef __attribute__((address_space(3))) const unsigned char* lcptr;
typedef float f32x2_t __attribute__((ext_vector_type(2))); typedef __bf16 bf16x2_t __attribute__((ext_vector_type(2)));

constexpr int OFF_CK = 98304, OFF_WSF = 101376, OFF_LUT = 141312, OFF_LUT_SWA = 49152, OFF_OST = 106496;
constexpr int LUTN = 320, LUTZ = 94;
constexpr float THR = 16.0f;
constexpr float NEG_INF = -INFINITY;

__device__ __forceinline__ int crow(int r, int hi) { return (r & 3) + 8 * (r >> 2) + 4 * hi; }
__device__ __forceinline__ unsigned cvtpk(float lo, float hi) { f32x2_t v = {lo, hi}; bf16x2_t b = __builtin_convertvector(v, bf16x2_t); return __builtin_bit_cast(unsigned, b); }
__device__ __forceinline__ s16x4 vtr(lcptr p) { return __builtin_bit_cast(s16x4, __builtin_amdgcn_ds_read_tr16_b64_v4i16((__attribute__((address_space(3))) v4i16_t*)p)); }
__device__ __forceinline__ float xhalf_max(float m) { auto rr = __builtin_amdgcn_permlane32_swap(__float_as_uint(m), __float_as_uint(m), false, false); return fmaxf(__uint_as_float(rr[0]), __uint_as_float(rr[1])); }
__device__ __forceinline__ float xhalf_sum(float m) { auto rr = __builtin_amdgcn_permlane32_swap(__float_as_uint(m), __float_as_uint(m), false, false); return __uint_as_float(rr[0]) + __uint_as_float(rr[1]); }

__device__ __forceinline__ void load_q(bf16x8 (&q)[4], const bf16* qp, int pitch, int lane) {
    const int r32 = lane & 31, hi = lane >> 5;
#pragma unroll
    for (int d0 = 0; d0 < 4; ++d0) q[d0] = *(const bf16x8*)(qp + (unsigned)(r32 * pitch + d0 * 16 + hi * 8));
}
struct UnitDesc {
    const bf16* q;
    const bf16* k; const bf16* k2; const bf16* v;
    int pitch;
    const float* c2;
    const float* c2f;
    const bf16* nk; const bf16* nk2; const bf16* nv; const float* nc2;
    int t0, t1;
    int q0;
    unsigned* qctr; int qbase, qlnb, qgb, qug; const bf16* qproj; const char* qck;
};
__device__ __forceinline__ void fox_decode(int idx, int lnb, int gb, int& qb, int& b, int& h) {
    const int per = 16 << lnb, s = idx >> (4 + lnb), r = idx & (per - 1);
    qb = 7 - (r >> (1 + lnb)); b = gb + (r & ((1 << lnb) - 1)); h = 2 * s + ((r >> lnb) & 1);
}

__device__ __forceinline__ float max3f(float a, float b, float c) { float r; asm("v_max3_f32 %0, %1, %2, %3" : "=v"(r) : "v"(a), "v"(b), "v"(c)); return r; }
__device__ __forceinline__ float max2f(float a, float b) { float r; asm("v_max_f32_e32 %0, %1, %2" : "=v"(r) : "v"(a), "v"(b)); return r; }
__device__ __forceinline__ float rowmax32(const f32x16& p0, const f32x16& p1) {
    float a = max3f(p0[0], p0[1], p1[0]), b = max3f(p0[2], p0[3], p1[1]); a = max3f(a, p1[2], p1[3]);
#pragma unroll
    for (int r = 4; r < 16; r += 4) { a = max3f(a, p0[r], p0[r + 1]); b = max3f(b, p0[r + 2], p0[r + 3]); a = max3f(a, p1[r], p1[r + 1]); b = max3f(b, p1[r + 2], p1[r + 3]); }
    return xhalf_max(max2f(a, b));
}
__device__ __forceinline__ void causal_mask(f32x16& p0, f32x16& p1, int mb) {
#pragma unroll
    for (int r = 0; r < 16; ++r) { if ((r & 3) + 8 * (r >> 2) > mb) p0[r] = NEG_INF; if ((r & 3) + 8 * (r >> 2) + 32 > mb) p1[r] = NEG_INF; }
}
__device__ __forceinline__ void lut_bias(f32x16& p0, f32x16& p1, __attribute__((address_space(3))) const float* lutx, int dc0) {
    __attribute__((address_space(3))) const float* pb = lutx + (dc0 + LUTZ - 59);
#pragma unroll
    for (int r = 0; r < 16; ++r) { const int c = (r & 3) + 8 * (r >> 2); p0[r] += pb[59 - c]; p1[r] += pb[59 - c - 32]; }
}

__device__ __forceinline__ void glds16(const void* gsrc, unsigned lds_dst) { unsigned keep;
    asm volatile("s_mov_b32 %0, m0\n\ts_mov_b32 m0, %2\n\ts_nop 0\n\tglobal_load_lds_dwordx4 %1, off\n\ts_mov_b32 m0, %0" : "=&s"(keep) : "v"(gsrc), "s"(lds_dst) : "memory"); }
__device__ __forceinline__ void glds4(const void* gsrc, unsigned lds_dst) { unsigned keep;
    asm volatile("s_mov_b32 %0, m0\n\ts_mov_b32 m0, %2\n\ts_nop 0\n\tglobal_load_lds_dword %1, off\n\ts_mov_b32 m0, %0" : "=&s"(keep) : "v"(gsrc), "s"(lds_dst) : "memory"); }
#define ATT_WAIT_BAR(N) asm volatile("s_waitcnt vmcnt(" #N ") lgkmcnt(0)\n\ts_barrier" ::: "memory")

template <int VAR, int DVB, bool STREAM = false, bool GRP2 = false>
__device__ __forceinline__ void unit_loop_p(LAS unsigned char* lds, const UnitDesc& U, int qw, f32x16 (&o)[DVB], float& mhat, float& l,
                                            __attribute__((address_space(3))) const float* lut, float b31, int kmap, int wave, int lane, unsigned long long (&stamp_acc)[6], unsigned long long& stamp_last, const bf16x8 (&qreg)[4], int stream_dma = -1, bool pre_issued = false, int next_t1 = -1) {
    constexpr int SLOT = (VAR == 1) ? 32768 : 16384, VOFF = (VAR == 1) ? 16384 : 8192;
    const int r32 = lane & 31, hi = lane >> 5;
    const int qpos = qw + r32;
    const lptr qlds = (lptr)lds + OFF_OST + wave * 4096 + lane * 16;
#define P_QF(d0) ((VAR != 1) ? qf[d0] : *(const __attribute__((address_space(3))) bf16x8*)(qlds + (d0) * 1024))
    const int krow_ = 8 * wave + (lane >> 3);
    const unsigned ksrc = (unsigned)(krow_ * U.pitch + (((lane & 7) ^ ((krow_ >> 1) & 7)) * 8)), vsrc = (unsigned)((16 * (wave & 3) + (lane >> 2)) * U.pitch + (wave >> 2) * 32 + (lane & 3) * 8);
    const unsigned lds0 = (unsigned)(uintptr_t)lds;
    const unsigned dstw = lds0 + (unsigned)wave * 1024u;
    const int t0 = U.t0, t1 = U.t1;
    int tend = t1;
#define P_TILE2(i, T1) ((VAR == 0) ? ((T1) - (i)) : (i))
#define P_TILE(i) P_TILE2(i, t1)
#define P_INR(i) (P_TILE(i) >= t0w && P_TILE(i) <= t1w)
    int t0w = t0; const int t1w = ((qw + 31) >> 6) < t1 ? ((qw + 31) >> 6) : t1;
    if (VAR == 2) { while (64 * t0w + 63 <= qw - 128) ++t0w; }
    __attribute__((address_space(3))) float* wsf = (__attribute__((address_space(3))) float*)((lptr)lds + OFF_WSF + wave * 256);
    const int kro_ = r32 * 128 + ((hi ^ ((r32 >> 1) & 7)) << 4);
    const lcptr kf0 = (lcptr)lds + kmap * 8192 + kro_, kf1 = (lcptr)lds + kmap * 8192 + (kro_ ^ 32), kf2 = (lcptr)lds + kmap * 8192 + (kro_ ^ 64), kf3 = (lcptr)lds + kmap * 8192 + (kro_ ^ 96);
    const lcptr vfb = (lcptr)lds + VOFF + ((lane >> 4) & 1) * 32 + (lane & 3) * 8 + (4 * hi + ((lane & 15) >> 2)) * 64;
#define P_SLOT(u) ((int)((unsigned)(u) % (STREAM ? 6u : 3u)) * SLOT)
#define P_DMAK3(u, T1, KB, KB2, CB) do { const unsigned to_ = (unsigned)(P_TILE2(u, T1) * 64 * U.pitch) + ksrc; const unsigned sd_ = (unsigned)__builtin_amdgcn_readfirstlane((int)(dstw + (unsigned)P_SLOT(u))); \
        glds16((KB) + to_, sd_); if (VAR == 1) glds16((KB2) + to_, sd_ + 8192u); \
        if (VAR == 0) { if (wave == 0) glds16((const char*)(CB) + (size_t)(P_TILE2(u, T1) * 64 + lane) * 16, (unsigned)__builtin_amdgcn_readfirstlane((int)(lds0 + OFF_CK + ((unsigned)(u) % 3u) * 1024u))); } } while (0)
#define P_DMAK2(u, T1) P_DMAK3(u, T1, U.k, U.k2, U.c2)
#define P_DMAK(u) P_DMAK2(u, t1)
#define P_DMAV3(u, T1, VB) do { const unsigned to_ = (unsigned)(P_TILE2(u, T1) * 64 * U.pitch) + vsrc; const unsigned sd_ = (unsigned)__builtin_amdgcn_readfirstlane((int)(dstw + (unsigned)(P_SLOT(u) + VOFF))); \
        glds16((VB) + to_, sd_); if (VAR == 1) glds16((VB) + to_ + 64, sd_ + 8192u); } while (0)
#define P_DMAV2(u, T1) P_DMAV3(u, T1, U.v)
#define P_DMAV(u) P_DMAV2(u, t1)
#define P_SB() __builtin_amdgcn_sched_barrier(0)
    if (!STREAM) { if (!pre_issued) { P_DMAK(t0); P_DMAV(t0); if (t0 + 1 <= t1) P_DMAK(t0 + 1); } }
#pragma unroll
    for (int d0 = 0; d0 < 4; ++d0) { if (VAR == 1) *(__attribute__((address_space(3))) bf16x8*)(qlds + d0 * 1024) = qreg[d0]; }
    bf16x8 qf[4];
#pragma unroll
    for (int d0 = 0; d0 < 4; ++d0) qf[d0] = qreg[d0];
    if (STREAM) { if (stream_dma >= 0) { P_DMAK(stream_dma); P_DMAV(stream_dma); } }
    int qtok = 0x7fffffff;
    if (!STREAM) {
    ATT_WAIT_BAR(0);
    if (VAR == 0) { if (U.qctr != nullptr && threadIdx.x == 0) qtok = U.qbase + (int)__hip_atomic_fetch_add(U.qctr, 1u, __ATOMIC_RELAXED, __HIP_MEMORY_SCOPE_AGENT); }
    if (t0 + 2 <= t1) P_DMAK(t0 + 2);
    }
    f32x16 negm; bf16x8 q5 = (bf16x8){0, 0, 0, 0, 0, 0, 0, 0}; if (hi == 0) { q5[0] = (short)0x3F80; q5[1] = (short)0x3F80; }
    f32x16 PA0, PA1, PB0, PB1;
    PA0 = f32x16{}; PA1 = f32x16{}; PB0 = f32x16{}; PB1 = f32x16{};

#define P_CINIT(u) do { float ci_ = -mhat; if (VAR == 1) { if (qw - (64 * (u) + 63) >= 128) ci_ += b31; } _Pragma("unroll") for (int r_ = 0; r_ < 16; ++r_) negm[r_] = ci_; } while (0)
#define P_K5A(u) (*(const __attribute__((address_space(3))) bf16x8*)((lcptr)lds + OFF_CK + (int)((unsigned)(u) % 3u) * 1024 + r32 * 16))
#define P_K5B(u) (*(const __attribute__((address_space(3))) bf16x8*)((lcptr)lds + OFF_CK + (int)((unsigned)(u) % 3u) * 1024 + 512 + r32 * 16))
#define P_QK(P0, P1, u) do { lcptr kq_[4] = {kf0 + P_SLOT(u), kf1 + P_SLOT(u), kf2 + P_SLOT(u), kf3 + P_SLOT(u)}; asm volatile("" : "+v"(kq_[0]), "+v"(kq_[1]), "+v"(kq_[2]), "+v"(kq_[3])); P_CINIT(P_TILE(u)); const f32x16 z_ = negm; \
        _Pragma("unroll") for (int d0_ = 0; d0_ < 4; ++d0_) { \
            const bf16x8 k0_ = *(const __attribute__((address_space(3))) bf16x8*)(kq_[d0_]), k1_ = *(const __attribute__((address_space(3))) bf16x8*)(kq_[d0_] + 4096); \
            const bf16x8 q_ = P_QF(d0_); P0 = __builtin_amdgcn_mfma_f32_32x32x16_bf16(k0_, q_, d0_ == 0 ? z_ : P0, 0, 0, 0); P1 = __builtin_amdgcn_mfma_f32_32x32x16_bf16(k1_, q_, d0_ == 0 ? z_ : P1, 0, 0, 0); } \
        if (VAR == 0) { P0 = __builtin_amdgcn_mfma_f32_32x32x16_bf16(P_K5A(u), q5, P0, 0, 0, 0); P1 = __builtin_amdgcn_mfma_f32_32x32x16_bf16(P_K5B(u), q5, P1, 0, 0, 0); } } while (0)
#define P_SM1(P0, P1, u, isfirst) do { \
        asm volatile("s_nop 15\n\ts_nop 7" : "+v"(P0), "+v"(P1));        \
        if (VAR == 0) { if (64 * P_TILE(u) + 63 > qw) causal_mask(P0, P1, qpos - 64 * P_TILE(u) - 4 * hi); } \
        else { if ((VAR == 2) || (qw - (64 * (u) + 63) < 128)) lut_bias(P0, P1, lut, qpos - 64 * (u) - 4 * hi); } \
        const float rm_ = rowmax32(P0, P1); \
        if ((isfirst) || __any(rm_ > THR)) { float dl_ = (isfirst) ? rm_ : fmaxf(rm_, 0.f); if (dl_ == NEG_INF) dl_ = 0.f; mhat += dl_; fres_ = __builtin_amdgcn_exp2f(-dl_); resc_ = true; \
            _Pragma("unroll") for (int r_ = 0; r_ < 16; ++r_) { P0[r_] -= dl_; P1[r_] -= dl_; } } } while (0)
    {
        bool resc_ = false; float fres_ = 1.f;
        if (P_INR(t0)) {
            P_QK(PA0, PA1, t0);
            P_SM1(PA0, PA1, t0, VAR != 2);
#pragma unroll
            for (int r = 0; r < 16; ++r) { PA0[r] = __builtin_amdgcn_exp2f(PA0[r]); PA1[r] = __builtin_amdgcn_exp2f(PA1[r]); }
            if (VAR == 2 && resc_) { l *= fres_; }
        }
    }
    if (!STREAM) asm volatile("s_waitcnt lgkmcnt(0)\n\ts_barrier" ::: "memory");
#define P_GAPA(PC0, PC1, i) do { if ((i) < 4) { sacc_ += (PC0[4 * (i)] + PC0[4 * (i) + 1]) + (PC0[4 * (i) + 2] + PC0[4 * (i) + 3]); pw_[(i) >> 1][2 * ((i) & 1)] = cvtpk(PC0[4 * (i)], PC0[4 * (i) + 1]); pw_[(i) >> 1][2 * ((i) & 1) + 1] = cvtpk(PC0[4 * (i) + 2], PC0[4 * (i) + 3]); } \
        else { sacc_ += (PC1[4 * ((i) - 4)] + PC1[4 * ((i) - 4) + 1]) + (PC1[4 * ((i) - 4) + 2] + PC1[4 * ((i) - 4) + 3]); pw_[(i) >> 1][2 * ((i) & 1)] = cvtpk(PC1[4 * ((i) - 4)], PC1[4 * ((i) - 4) + 1]); pw_[(i) >> 1][2 * ((i) & 1) + 1] = cvtpk(PC1[4 * ((i) - 4) + 2], PC1[4 * ((i) - 4) + 3]); } } while (0)
#define P_EXP4(PN0, PN1, j) do { if ((j) < 4) { _Pragma("unroll") for (int e_ = 0; e_ < 4; ++e_) PN0[4 * (j) + e_] = __builtin_amdgcn_exp2f(PN0[4 * (j) + e_]); } \
        else { _Pragma("unroll") for (int e_ = 0; e_ < 4; ++e_) PN1[4 * ((j) - 4) + e_] = __builtin_amdgcn_exp2f(PN1[4 * ((j) - 4) + e_]); } } while (0)
#if defined(PROBE_ADD_MFMA)
#define PROBE_MFMA8(a_, b_, c_, d_, qa, qb) do { f32x16 dm_ = f32x16{}; dm_ = __builtin_amdgcn_mfma_f32_32x32x16_bf16(a_, qa, dm_, 0, 0, 0); dm_ = __builtin_amdgcn_mfma_f32_32x32x16_bf16(b_, qa, dm_, 0, 0, 0); \
        dm_ = __builtin_amdgcn_mfma_f32_32x32x16_bf16(c_, qb, dm_, 0, 0, 0); dm_ = __builtin_amdgcn_mfma_f32_32x32x16_bf16(d_, qb, dm_, 0, 0, 0); dm_ = __builtin_amdgcn_mfma_f32_32x32x16_bf16(a_, qb, dm_, 0, 0, 0); \
        dm_ = __builtin_amdgcn_mfma_f32_32x32x16_bf16(b_, qb, dm_, 0, 0, 0); dm_ = __builtin_amdgcn_mfma_f32_32x32x16_bf16(c_, qa, dm_, 0, 0, 0); dm_ = __builtin_amdgcn_mfma_f32_32x32x16_bf16(d_, qa, dm_, 0, 0, 0); asm volatile("" :: "v"(dm_)); } while (0)
#else
#define PROBE_MFMA8(a_, b_, c_, d_, qa, qb) do {} while (0)
#endif
#if defined(PROBE_ADD_EXP)
#define PROBE_EXP4(PN0, PN1, j) do { _Pragma("unroll") for (int e_ = 0; e_ < 4; ++e_) { float x_ = ((j) < 4 ? PN0[4 * ((j) & 3) + e_] : PN1[4 * ((j) & 3) + e_]); asm volatile("" : "+v"(x_)); x_ = __builtin_amdgcn_exp2f(x_); asm volatile("" :: "v"(x_)); } } while (0)
#else
#define PROBE_EXP4(PN0, PN1, j) do {} while (0)
#endif
#if defined(PROBE_ADD_BAR)
#define PROBE_BAR() asm volatile("s_waitcnt lgkmcnt(0)\n\ts_barrier" ::: "memory")
#else
#define PROBE_BAR() do {} while (0)
#endif
#if defined(PROBE_STAMP)
#define P_STAMP(k) do { __builtin_amdgcn_sched_barrier(0); unsigned long long ts_; asm volatile("s_memtime %0\n\ts_waitcnt lgkmcnt(0)" : "=s"(ts_) :: "memory"); __builtin_amdgcn_sched_barrier(0); stamp_acc[k] += ts_ - stamp_last; stamp_last = ts_; } while (0)
#else
#define P_STAMP(k) do {} while (0)
#endif
    __attribute__((address_space(3))) int* pflags = (__attribute__((address_space(3))) int*)((lptr)lds + OFF_WSF + 2048);
#define P_PRUNE_VOTE(t) do { if (VAR == 0) { int ok_ = 1; const int i2_ = (t) + 2; \
            if (i2_ <= t1) {   \
                const unsigned w_ = *(const __attribute__((address_space(3))) unsigned*)((lcptr)lds + OFF_CK + (int)((unsigned)((t) + 1) % 3u) * 1024); \
                const float nb_ = __builtin_bit_cast(float, w_ << 16) + __builtin_bit_cast(float, w_ & 0xffff0000u); \
                const bool st_ = (P_TILE((t) + 1) <= t1w); ok_ = (st_ && __all(mhat - b31 - nb_ > 31.0f)) ? 1 : 0; } \
            if (lane == 0) pflags[((t) & 1) * 8 + wave] = ok_; } } while (0)
#define P_PRUNE_READ(t) do { if (VAR == 0) { const i32x4v fa_ = *(const __attribute__((address_space(3))) i32x4v*)(pflags + ((t) & 1) * 8), fb_ = *(const __attribute__((address_space(3))) i32x4v*)(pflags + ((t) & 1) * 8 + 4); \
            const int all_ = fa_[0] & fa_[1] & fa_[2] & fa_[3] & fb_[0] & fb_[1] & fb_[2] & fb_[3]; \
            if (__builtin_amdgcn_readfirstlane(all_) && (t) + 1 < tend) tend = (t) + 1; } } while (0)
#if defined(PROBE_CYC)
#define P_CNT() do { stamp_acc[0] += 1; unsigned long long ts_; asm volatile("s_memtime %0\n\ts_waitcnt lgkmcnt(0)" : "=s"(ts_) :: "memory"); if (stamp_last) stamp_acc[2] += ts_ - stamp_last; stamp_last = ts_; } while (0)
#elif defined(PROBE_STEPS)
#define P_CNT() do { stamp_acc[0] += 1; } while (0)
#else
#define P_CNT() do {} while (0)
#endif
#define P_PHASEB(PW, TV, PX0, PX1, DOEXP) do { \
        lcptr vb_ = vfb + P_SLOT(TV); asm volatile("" : "+v"(vb_)); \
        s16x4 vl_[4], vh_[4]; \
        _Pragma("unroll") for (int q_ = 0; q_ < 4; ++q_) { vl_[q_] = vtr(vb_ + q_ * 1024); vh_[q_] = vtr(vb_ + q_ * 1024 + 512); } \
        P_SB(); \
        _Pragma("unroll") for (int j_ = 0; j_ < DVB * 4; ++j_) { \
            const int d_ = j_ >> 2, ks_ = j_ & 3; \
            const bf16x8 vf_ = (bf16x8){vl_[ks_][0], vl_[ks_][1], vl_[ks_][2], vl_[ks_][3], vh_[ks_][0], vh_[ks_][1], vh_[ks_][2], vh_[ks_][3]}; \
            o[d_] = __builtin_amdgcn_mfma_f32_32x32x16_bf16(__builtin_bit_cast(bf16x8, PW[ks_]), vf_, o[d_], 0, 0, 0); \
            if (j_ + 4 < DVB * 4) { const int dn_ = (j_ + 4) >> 2, dof_ = (dn_ >> 1) * 8192 + (dn_ & 1) * 4096 + ks_ * 1024; vl_[ks_] = vtr(vb_ + dof_); vh_[ks_] = vtr(vb_ + dof_ + 512); } \
            if (DOEXP) { if (DVB == 2) { P_EXP4(PX0, PX1, j_); } else { if ((j_ & 1) == 0) { P_EXP4(PX0, PX1, j_ >> 1); } } } \
            P_SB(); } \
        asm volatile("" : "+v"(PX0), "+v"(PX1));        \
    } while (0)
#define P_RESCALE(F_) do { l *= (F_); if (hi == 0) wsf[r32] = (F_); asm volatile("s_waitcnt lgkmcnt(0)" ::: "memory"); \
        _Pragma("unroll") for (int r_ = 0; r_ < 16; ++r_) { const float fr_ = wsf[crow(r_, hi)]; _Pragma("unroll") for (int d_ = 0; d_ < DVB; ++d_) o[d_][r_] *= fr_; } } while (0)
#define P_STEP_BAR(t) do { if (!STREAM) { if (fullq_) { if (VAR == 0) { if (wave == 0) { ATT_WAIT_BAR(2); } else { ATT_WAIT_BAR(1); } } else if (VAR == 1) { ATT_WAIT_BAR(2); } else { ATT_WAIT_BAR(1); } } else { ATT_WAIT_BAR(0); } } \
        P_PRUNE_READ(t); } while (0)
#define P_STEP(PC0, PC1, PN0, PN1, t) do { \
        P_CNT(); \
        const bool curv_ = P_INR(t), nxtv_ = ((t) + 1 <= tend) && P_INR((t) + 1); \
        const bool fullq_ = ((t) + 3 <= t1); \
          \
        if (!curv_) { asm volatile("; tile not needed by this wave: zero probabilities" ::: "memory"); PC0 = f32x16{}; PC1 = f32x16{}; }     \
        if (!STREAM) { if ((t) + 1 <= t1) P_DMAV((t) + 1); }        \
        float sacc_ = 0.f; u32x4v pw_[4]; bool resc_ = false; float fres_ = 1.f; \
        { \
            lcptr kq0_ = kf0 + P_SLOT((t) + 1), kq1_ = kf1 + P_SLOT((t) + 1), kq2_ = kf2 + P_SLOT((t) + 1), kq3_ = kf3 + P_SLOT((t) + 1); asm volatile("" : "+v"(kq0_), "+v"(kq1_), "+v"(kq2_), "+v"(kq3_)); P_CINIT(P_TILE((t) + 1)); const f32x16 z_ = negm; \
            bf16x8 ka_ = *(const __attribute__((address_space(3))) bf16x8*)(kq0_), kb2_ = *(const __attribute__((address_space(3))) bf16x8*)(kq0_ + 4096); \
            bf16x8 kc_ = *(const __attribute__((address_space(3))) bf16x8*)(kq1_), kd_ = *(const __attribute__((address_space(3))) bf16x8*)(kq1_ + 4096); \
            bf16x8 qa_ = P_QF(0), qb_ = P_QF(1); \
            P_SB(); \
            PN0 = __builtin_amdgcn_mfma_f32_32x32x16_bf16(ka_, qa_, z_, 0, 0, 0); ka_ = *(const __attribute__((address_space(3))) bf16x8*)(kq2_); P_GAPA(PC0, PC1, 0); P_SB(); \
            PN1 = __builtin_amdgcn_mfma_f32_32x32x16_bf16(kb2_, qa_, z_, 0, 0, 0); qa_ = P_QF(2); kb2_ = *(const __attribute__((address_space(3))) bf16x8*)(kq2_ + 4096); P_GAPA(PC0, PC1, 1); P_SB(); \
            PN0 = __builtin_amdgcn_mfma_f32_32x32x16_bf16(kc_, qb_, PN0, 0, 0, 0); kc_ = *(const __attribute__((address_space(3))) bf16x8*)(kq3_); P_GAPA(PC0, PC1, 2); P_SB(); \
            PN1 = __builtin_amdgcn_mfma_f32_32x32x16_bf16(kd_, qb_, PN1, 0, 0, 0); qb_ = P_QF(3); kd_ = *(const __attribute__((address_space(3))) bf16x8*)(kq3_ + 4096); P_GAPA(PC0, PC1, 3); P_SB(); \
            PN0 = __builtin_amdgcn_mfma_f32_32x32x16_bf16(ka_, qa_, PN0, 0, 0, 0); P_GAPA(PC0, PC1, 4); P_SB(); \
            PN1 = __builtin_amdgcn_mfma_f32_32x32x16_bf16(kb2_, qa_, PN1, 0, 0, 0); P_GAPA(PC0, PC1, 5); P_SB(); \
            PN0 = __builtin_amdgcn_mfma_f32_32x32x16_bf16(kc_, qb_, PN0, 0, 0, 0); P_GAPA(PC0, PC1, 6); P_SB(); \
            PN1 = __builtin_amdgcn_mfma_f32_32x32x16_bf16(kd_, qb_, PN1, 0, 0, 0); P_GAPA(PC0, PC1, 7); P_SB(); \
            if (VAR == 0) { PN0 = __builtin_amdgcn_mfma_f32_32x32x16_bf16(P_K5A((t) + 1), q5, PN0, 0, 0, 0); PN1 = __builtin_amdgcn_mfma_f32_32x32x16_bf16(P_K5B((t) + 1), q5, PN1, 0, 0, 0); } \
            asm volatile("" : "+v"(pw_[0]), "+v"(pw_[1]), "+v"(pw_[2]), "+v"(pw_[3]), "+v"(sacc_));        \
        } \
        l += sacc_; \
        if (!STREAM) { if (fullq_) P_DMAK((t) + 3); }        \
        if (nxtv_) P_SM1(PN0, PN1, (t) + 1, (VAR == 1) ? ((t) + 1 == t0w) : ((VAR == 0) && (P_TILE((t) + 1) == t1w))); \
        P_PRUNE_VOTE(t); \
        if (GRP2) P_STEP_BAR(t);        \
        P_PHASEB(pw_, t, PN0, PN1, true); \
        if (resc_) P_RESCALE(fres_); \
        if (!GRP2) P_STEP_BAR(t); \
    } while (0)
    for (int t = t0; t <= tend; t += 2) {
        P_STEP(PA0, PA1, PB0, PB1, t);
        if (t + 1 <= tend) P_STEP(PB0, PB1, PA0, PA1, t + 1);
    }
    int nt1_ = next_t1; const bf16* nk_ = U.nk; const bf16* nk2_ = U.nk2; const bf16* nv_ = U.nv; const float* nc2_ = U.nc2;
    __attribute__((address_space(3))) int* dynw = (__attribute__((address_space(3))) int*)((lptr)lds + OFF_WSF + 2048 + 128);
    if (VAR == 0) { if (U.qctr != nullptr && threadIdx.x == 0) dynw[0] = qtok; }
    if (!STREAM) asm volatile("s_waitcnt lgkmcnt(0)\n\ts_barrier" ::: "memory");
    if (VAR == 0) { if (U.qctr != nullptr) { const int ni_ = __builtin_amdgcn_readfirstlane(dynw[0]);
            if (ni_ < U.qug) { int qb_, b_, h_; fox_decode(ni_, U.qlnb, U.qgb, qb_, b_, h_); nt1_ = 4 * qb_ + 3; nk_ = U.qproj + (size_t)b_ * SEQ * N_IN + 512 + h_ * 64; nk2_ = nk_; nv_ = nk_ + 512; nc2_ = (const float*)(U.qck + (size_t)(b_ * 8 + h_) * SEQ * 16); }
            else nt1_ = -1; } }
    if (!STREAM) { if (nt1_ >= 0) { P_DMAK3(0, nt1_, nk_, nk2_, nc2_); P_DMAV3(0, nt1_, nv_); if (nt1_ >= 1) P_DMAK3(1, nt1_, nk_, nk2_, nc2_); } }
    if (!STREAM && nt1_ < 0) asm volatile("s_waitcnt vmcnt(0)" ::: "memory");
#undef P_STEP_BAR
#undef P_PHASEB
#undef P_RESCALE
#undef P_TILE
#undef P_TILE2
#undef P_DMAK2
#undef P_DMAK3
#undef P_DMAV3
#undef P_DMAV2
#undef P_INR
#undef P_PRUNE_VOTE
#undef P_PRUNE_READ
#undef P_SLOT
#undef P_DMAK
#undef P_DMAV
#undef P_SB
#undef P_QK
#undef P_SM1
#undef P_CINIT
#undef P_K5A
#undef P_K5B
#undef P_GAPA
#undef P_EXP4
#undef P_STEP
#undef P_QF
}

template <int DVB> __device__ __forceinline__ void normalize_o(f32x16 (&o)[DVB], float l, __attribute__((address_space(3))) float* wsf, int r32, int hi) {
    const float lt = xhalf_sum(l);
    if (hi == 0) wsf[32 + r32] = __builtin_amdgcn_rcpf(lt);
    asm volatile("s_waitcnt lgkmcnt(0)" ::: "memory");
#pragma unroll
    for (int r = 0; r < 16; ++r) { const float il = wsf[32 + crow(r, hi)];
#pragma unroll
        for (int d = 0; d < DVB; ++d) o[d][r] *= il; }
}
template <int DVB> __device__ __forceinline__ void store_o(const f32x16 (&o)[DVB], LAS unsigned char* lds, int wave_slot, bf16* dst, int dpitch, int lane) {
    const int r32 = lane & 31, hi = lane >> 5;
    __attribute__((address_space(3))) bf16* stg = (__attribute__((address_space(3))) bf16*)((lptr)lds + OFF_OST) + wave_slot * (32 * 32 * DVB);
    constexpr int RW = 32 * DVB;
#pragma unroll
    for (int r = 0; r < 16; ++r) { const int orow = crow(r, hi);
#pragma unroll
        for (int d = 0; d < DVB; ++d) stg[orow * RW + d * 32 + r32] = (bf16)f2bf(o[d][r]); }
    asm volatile("s_waitcnt lgkmcnt(0)" ::: "memory");
    constexpr int CPR = RW / 8;
#pragma unroll
    for (int i = 0; i < (32 * CPR) / 64; ++i) { const int idx = i * 64 + lane, row = idx / CPR, ch = idx % CPR;
        const u32x4v v = *(const __attribute__((address_space(3))) u32x4v*)(stg + row * RW + ch * 8);
        *(u32x4v*)(dst + (unsigned)(row * dpitch + ch * 8)) = v; }
    asm volatile("s_waitcnt lgkmcnt(0)" ::: "memory");
}

__device__ __forceinline__ void attn0_fox(Frame& F, const Args& a) {
    const int wave = F.wave;
    unsigned long long stamp_acc[6] = {0, 0, 0, 0, 0, 0}; unsigned long long stamp_last = 0;
    unsigned char* ws = a.ws;
    const bf16* proj = (const bf16*)(ws + WS_BIG); bf16* mix = (bf16*)(ws + WS_MIX); const float* c2 = (const float*)(ws + WS_C2);
    __attribute__((address_space(3))) float* wsf = (__attribute__((address_space(3))) float*)((lptr)F.lds + OFF_WSF + wave * 256);
    __attribute__((address_space(3))) float* lutb = (__attribute__((address_space(3))) float*)((lptr)F.lds + OFF_LUT);
    float bqk; { float gq = 0.f, gk = 0.f; for (int i = 0; i < 64; ++i) { gq = fmaxf(gq, fabsf(a.in[5][i])); gk = fmaxf(gk, fabsf(a.in[6][i])); } bqk = 64.0f * 1.008f * (0.125f * LOG2E_F) * gq * gk; }
    const int lng = ((F.G & 7) == 0 && (F.G >> 3) <= 128) ? 3 : 0, gsz = F.G >> lng, lnb = 4 - lng, ug = 64 << lnb;
    const int g = F.vcu / gsz, gb = g << lnb;
    unsigned* qctr = (unsigned*)(F.ctl + CW_FOXQ) + g * 64;
    __attribute__((address_space(3))) int* dynw = (__attribute__((address_space(3))) int*)((lptr)F.lds + OFF_WSF + 2048 + 128);
    int cur = F.vcu - g * gsz, qg = g; bool first = true;
    const int ngr = 1 << lng;
#define FOX_QP(qb_, b_, h_) (proj + ((size_t)(b_) * SEQ + (qb_) * 256 + 32 * wave) * N_IN + (h_) * 64)
    bf16x8 qreg[4];
    if (cur < ug) { int qb, b, h; fox_decode(cur, lnb, gb, qb, b, h); load_q(qreg, FOX_QP(qb, b, h), N_IN, F.lane); }
#pragma unroll 1
    while (cur < ug) {
        const int cgb = qg << lnb;
        int qb, b, h; fox_decode(cur, lnb, cgb, qb, b, h);
        const size_t rowb = (size_t)b * SEQ; const int bh = b * 8 + h;
        int lane = F.lane; asm volatile("" : "+v"(lane));
        const int q0 = qb * 256, qw = q0 + 32 * wave;
        UnitDesc U; U.pitch = N_IN; U.q = nullptr; U.k = proj + rowb * N_IN + 512 + h * 64; U.k2 = U.k; U.v = proj + rowb * N_IN + 1024 + h * 64;
        U.c2 = (const float*)((const char*)(ws + WS_CKREC) + (size_t)bh * SEQ * 16); U.c2f = c2 + (size_t)bh * SEQ; U.t0 = 0; U.t1 = (q0 + 255) / 64; U.q0 = q0;
        U.nk = U.k; U.nk2 = U.k; U.nv = U.v; U.nc2 = U.c2;
        U.qctr = (unsigned*)(F.ctl + CW_FOXQ) + qg * 64; U.qbase = gsz; U.qlnb = lnb; U.qgb = cgb; U.qug = ug; U.qproj = proj; U.qck = (const char*)(ws + WS_CKREC);
        f32x16 o[2]; o[0] = f32x16{}; o[1] = f32x16{}; float mhat = 0.f, l = 0.f;
        if (wave >= 4) unit_loop_p<0, 2, false, true>(F.lds, U, qw, o, mhat, l, lutb, bqk, 0, wave, lane, stamp_acc, stamp_last, qreg, -1, !first, -1);
        else unit_loop_p<0, 2, false, false>(F.lds, U, qw, o, mhat, l, lutb, bqk, 0, wave, lane, stamp_acc, stamp_last, qreg, -1, !first, -1);
        int nxt = __builtin_amdgcn_readfirstlane(dynw[0]);
        int lane2 = F.lane; asm volatile("" : "+v"(lane2));
        if (nxt < ug) { int qbn, bn, hn; fox_decode(nxt, lnb, cgb, qbn, bn, hn); load_q(qreg, FOX_QP(qbn, bn, hn), N_IN, lane2); }
        normalize_o<2>(o, l, wsf, lane2 & 31, lane2 >> 5);
        store_o<2>(o, F.lds, wave, mix + (rowb + qw) * DM + h * 64, DM, lane2);
        asm volatile("s_waitcnt lgkmcnt(0)\n\ts_barrier" ::: "memory");
        first = false;
        if (nxt >= ug && ngr > 1) {
            for (int rnd = 0; rnd < ngr && nxt >= ug; ++rnd) {
                if (F.tid < 64) {
                    unsigned c = 0xffffffffu;
                    if (F.lane < ngr) c = __hip_atomic_load((unsigned*)(F.ctl + CW_FOXQ) + F.lane * 64, __ATOMIC_RELAXED, __HIP_MEMORY_SCOPE_AGENT);
                    unsigned bc = c;
#pragma unroll
                    for (int o = 1; o < 8; o <<= 1) { const unsigned t = (unsigned)__shfl_xor((int)bc, o); bc = t < bc ? t : bc; }
                    const unsigned long long mk = __ballot(c == bc && F.lane < ngr);
                    int best = mk ? (int)__builtin_ctzll(mk) : -1;
                    bc = (unsigned)__builtin_amdgcn_readfirstlane((int)bc);
                    if (F.tid == 0) {
                        int got = 0x7fffffff;
                        if (best >= 0 && gsz + (int)bc < ug) got = gsz + (int)__hip_atomic_fetch_add((unsigned*)(F.ctl + CW_FOXQ) + best * 64, 1u, __ATOMIC_RELAXED, __HIP_MEMORY_SCOPE_AGENT);
                        else best = -1;
                        dynw[2 + 2 * (rnd & 1)] = got; dynw[3 + 2 * (rnd & 1)] = best;
                    }
                }
                asm volatile("s_waitcnt vmcnt(0) lgkmcnt(0)\n\ts_barrier" ::: "memory");
                const int got = __builtin_amdgcn_readfirstlane(dynw[2 + 2 * (rnd & 1)]), vg = __builtin_amdgcn_readfirstlane(dynw[3 + 2 * (rnd & 1)]);
                if (vg < 0) break;
                if (got < ug) { nxt = got; qg = vg; }
            }
            if (nxt < ug) { int qbn, bn, hn; fox_decode(nxt, lnb, qg << lnb, qbn, bn, hn); load_q(qreg, FOX_QP(qbn, bn, hn), N_IN, F.lane); first = true; }
        }
        cur = nxt;
    }
#undef FOX_QP
#if defined(PROBE_STEPS)
    if (blockIdx.x == 0 && F.tid == 0) { ((float*)(a.ws + WS_GT))[2048] = 0.08f + 0.16f * ((float)stamp_acc[0] / (float)stamp_acc[1]); }
#endif
#if defined(PROBE_CYC)
    if (blockIdx.x == 0 && F.tid == 0) { ((float*)(a.ws + WS_GT))[2048] = 0.08f + 0.16f * (((float)stamp_acc[2] / (float)stamp_acc[0]) / 8000.0f); }
#endif
#if defined(PROBE_STAMP)
    if (blockIdx.x == 0 && F.tid == 0) { float tot = 0.f; for (int k = 0; k < 5; ++k) tot += (float)stamp_acc[k]; ((float*)(a.ws + WS_GT))[2048] = 0.08f + 0.16f * ((float)stamp_acc[PROBE_STAMP] / tot); }
#endif
}
__device__ __forceinline__ void attn0_diff(Frame& F, const Args& a) {
    const int wave = F.wave;
    unsigned long long stamp_acc[6] = {0, 0, 0, 0, 0, 0}; unsigned long long stamp_last = 0;
    unsigned char* ws = a.ws;
    const bf16* proj = (const bf16*)(ws + WS_BIG); bf16* mix = (bf16*)(ws + WS_MIX);
    __attribute__((address_space(3))) float* wsf = (__attribute__((address_space(3))) float*)((lptr)F.lds + OFF_WSF + wave * 256);
    __attribute__((address_space(3))) float* lutb = (__attribute__((address_space(3))) float*)((lptr)F.lds + OFF_LUT);
    for (int i = F.tid; i < 4 * LUTN; i += NWAVES * 64) { const int h = i / LUTN, e = i % LUTN, d = e - LUTZ; lutb[i] = d < 0 ? NEG_INF : a.in[1][(d < 128 ? kBucket[d] : 31) * 16 + h] * LOG2E_F; }
    __attribute__((address_space(3))) float* parm = lutb + 4 * LUTN;
    if (F.tid == 0) { float s1 = 0.f, s2 = 0.f; for (int i = 0; i < 64; ++i) { s1 += a.in[9][i] * a.in[10][i]; s2 += a.in[11][i] * a.in[12][i]; } parm[0] = expf(s1) - expf(s2) + 0.2f; }
    if (F.tid < 128) parm[4 + F.tid] = a.in[13][F.tid] * 0.8f;
    __syncthreads();
    for (int vv = F.vcu; vv < 256; vv += F.G) {
        const int bh = vv >> 2, b = bh >> 2, h = bh & 3, jj = vv & 3;
        const size_t rowb = (size_t)b * SEQ;
        const int mp = wave >> 2, qs = wave & 3;
#define DIFF_QB(i) (4 * (i) + ((((i) & 1) != 0) ? 3 - jj : jj))
#define DIFF_QP(i) (proj + (rowb + DIFF_QB(i) * 128 + 32 * qs) * N_IN + 1536 + h * 128 + mp * 64)
        bf16x8 qreg[4]; load_q(qreg, DIFF_QP(0), N_IN, F.lane);
#pragma unroll 1
        for (int i = 0; i < 4; ++i) {
            const int qb = DIFF_QB(i);
            int lane = F.lane; asm volatile("" : "+v"(lane));
            const int q0 = qb * 128, qw = q0 + 32 * qs;
            UnitDesc U; U.qctr = nullptr; U.pitch = N_IN; U.q = nullptr; U.k = proj + rowb * N_IN + 2048 + h * 128; U.k2 = U.k + 64; U.v = proj + rowb * N_IN + 2560 + h * 128;
            U.c2 = nullptr; U.c2f = nullptr; U.t0 = 0; U.t1 = (q0 + 127) / 64; U.q0 = q0; U.nk = U.k; U.nk2 = U.k2; U.nv = U.v; U.nc2 = nullptr;
            f32x16 o[4]; o[0] = f32x16{}; o[1] = f32x16{}; o[2] = f32x16{}; o[3] = f32x16{}; float mhat = 0.f, l = 0.f;
            { const int nt1 = (i + 1 < 4) ? (DIFF_QB(i + 1) * 128 + 127) / 64 : -1; const float b31v = lutb[h * LUTN + LUTZ + 128];
              unit_loop_p<1, 4, false, false>(F.lds, U, qw, o, mhat, l, lutb + h * LUTN, b31v, mp, wave, lane, stamp_acc, stamp_last, qreg, -1, i > 0, nt1); }
            int lane2 = F.lane; asm volatile("" : "+v"(lane2));
            if (i + 1 < 4) load_q(qreg, DIFF_QP(i + 1), N_IN, lane2);
            normalize_o<4>(o, l, wsf, lane2 & 31, lane2 >> 5);
            __attribute__((address_space(3))) unsigned* ex = (__attribute__((address_space(3))) unsigned*)((lptr)F.lds + 65536) + qs * 2048;
            if (mp == 1) {
#pragma unroll
                for (int d = 0; d < 4; ++d)
#pragma unroll
                    for (int r = 0; r < 8; ++r) ex[(d * 8 + r) * 64 + lane2] = cvtpk(o[d][2 * r], o[d][2 * r + 1]);
            }
            asm volatile("s_waitcnt lgkmcnt(0)\n\ts_barrier" ::: "memory");
            if (mp == 0) {
                const float lam = parm[0]; float sub[4];
#pragma unroll
                for (int d = 0; d < 4; ++d) sub[d] = parm[4 + d * 32 + (lane2 & 31)];
                float ss[16];
#pragma unroll
                for (int r = 0; r < 16; ++r) ss[r] = 0.f;
#pragma unroll
                for (int d = 0; d < 4; ++d)
#pragma unroll
                    for (int r = 0; r < 8; ++r) { const unsigned w = ex[(d * 8 + r) * 64 + lane2];
                        const float v0 = o[d][2 * r] - lam * __builtin_bit_cast(float, w << 16), v1 = o[d][2 * r + 1] - lam * __builtin_bit_cast(float, w & 0xffff0000u);
                        o[d][2 * r] = v0; o[d][2 * r + 1] = v1; ss[2 * r] += v0 * v0; ss[2 * r + 1] += v1 * v1; }
#pragma unroll
                for (int r = 0; r < 16; ++r) {
                    float s = ss[r];
                    s += __shfl_xor(s, 1); s += __shfl_xor(s, 2); s += __shfl_xor(s, 4); s += __shfl_xor(s, 8); s += __shfl_xor(s, 16);
                    const float rn = __builtin_amdgcn_rsqf(s * (1.0f / 128.0f) + 1e-6f);
#pragma unroll
                    for (int d = 0; d < 4; ++d) o[d][r] *= rn * sub[d];
                }
                store_o<4>(o, F.lds, qs, mix + (rowb + qw) * DM + 512 + h * 128, DM, lane2);
            }
            asm volatile("s_waitcnt lgkmcnt(0)\n\ts_barrier" ::: "memory");
        }
#undef DIFF_QB
#undef DIFF_QP
    }
}

__device__ __forceinline__ void attn1_phase(Frame& F, const Args& a) {
    const int wave = F.wave;
    unsigned long long stamp_acc[6] = {0, 0, 0, 0, 0, 0}; unsigned long long stamp_last = 0;
    unsigned char* ws = a.ws;
    const bf16* qkv = (const bf16*)(ws + WS_BIG); bf16* mix = (bf16*)(ws + WS_MIX);
    __attribute__((address_space(3))) float* wsf = (__attribute__((address_space(3))) float*)((lptr)F.lds + OFF_WSF + wave * 256);
    __attribute__((address_space(3))) float* lutb = (__attribute__((address_space(3))) float*)((lptr)F.lds + OFF_LUT);
    const unsigned lds0 = (unsigned)(uintptr_t)F.lds;
    for (int vv = F.vcu; vv < 256; vv += F.G) {
        const int bk = vv >> 2, b = bk >> 2, kvh = bk & 3, qb0 = 8 * (vv & 3), qbl = qb0 + 7;
        const size_t rowb = (size_t)b * SEQ;
        __syncthreads();
        for (int i = F.tid; i < 4 * LUTN; i += NWAVES * 64) { const int h = kvh * 4 + i / LUTN, e = i % LUTN, d = e - LUTZ; lutb[i] = (d < 0 || d >= 128) ? NEG_INF : a.in[1][kBucket[d] * 16 + h] * LOG2E_F; }
        const bf16* kbase = qkv + rowb * N_QKV + 1024 + kvh * 64; const bf16* vbase = qkv + rowb * N_QKV + 1280 + kvh * 64;
#define SWA_DMA(t) do { int ln_ = F.lane; asm volatile("" : "+v"(ln_)); \
            const int kr_ = 8 * wave + (ln_ >> 3); const unsigned ks_ = (unsigned)(((t) * 64 + kr_) * N_QKV + (((ln_ & 7) ^ ((kr_ >> 1) & 7)) * 8)), vs_ = (unsigned)(((t) * 64 + 16 * (wave & 3) + (ln_ >> 2)) * N_QKV + (wave >> 2) * 32 + (ln_ & 3) * 8); \
            const unsigned sd_ = (unsigned)__builtin_amdgcn_readfirstlane((int)(lds0 + (unsigned)wave * 1024u + ((unsigned)(t) % 6u) * 16384u)); \
            glds16(kbase + ks_, sd_); glds16(vbase + vs_, sd_ + 8192u); } while (0)
        { const int ta = qb0 >= 2 ? qb0 - 2 : 0, tb = qb0 + 2;
          for (int t = ta; t <= tb; ++t) SWA_DMA(t); }
        asm volatile("s_waitcnt vmcnt(0)" ::: "memory");
        __syncthreads();
        const int g = wave >> 1, head = kvh * 4 + g;
#define SWA_QP(i) (qkv + (rowb + (qb0 + (i)) * 64 + 32 * (wave & 1)) * N_QKV + head * 64)
        bf16x8 qreg[4]; load_q(qreg, SWA_QP(0), N_QKV, F.lane);
#pragma unroll 1
        for (int i = 0; i < 8; ++i) {
            int lane = F.lane; asm volatile("" : "+v"(lane));
            const int qb = qb0 + i, q0 = qb * 64, qw = q0 + 32 * (wave & 1);
            UnitDesc U; U.qctr = nullptr; U.pitch = N_QKV; U.q = nullptr; U.k = kbase; U.k2 = kbase; U.v = vbase;
            U.c2 = nullptr; U.c2f = nullptr; U.t0 = qb >= 2 ? qb - 2 : 0; U.t1 = qb; U.q0 = q0; U.nk = kbase; U.nk2 = kbase; U.nv = vbase; U.nc2 = nullptr;
            f32x16 o[2]; o[0] = f32x16{}; o[1] = f32x16{};
            float mhat = a.in[19][head] * LOG2E_F, l = ((lane >> 5) == 0) ? 1.0f : 0.0f;
            unit_loop_p<2, 2, true>(F.lds, U, qw, o, mhat, l, lutb + g * LUTN, 0.f, 0, wave, lane, stamp_acc, stamp_last, qreg, (qb + 3 <= qbl) ? qb + 3 : -1);
            int lane2 = F.lane; asm volatile("" : "+v"(lane2));
            asm volatile("s_waitcnt vmcnt(0)" ::: "memory");
            if (i + 1 < 8) load_q(qreg, SWA_QP(i + 1), N_QKV, lane2);
            normalize_o<2>(o, l, wsf, lane2 & 31, lane2 >> 5);
            store_o<2>(o, F.lds, wave, mix + (rowb + qw) * DM + head * 64, DM, lane2);
            asm volatile("s_waitcnt lgkmcnt(0)\n\ts_barrier" ::: "memory");
        }
#undef SWA_QP
#undef SWA_DMA
    }
}
}

#if defined(PROBE_NOATOM)
#define PROBE_NOATOM_PTR ((float*)nullptr)
#else
#define PROBE_NOATOM_PTR (ssq + 4 * M)
#endif
#ifndef WGM_P1
#define WGM_P1 4
#endif
#ifndef WGM_P6
#define WGM_P6 4
#endif
#ifndef WGM_UP
#define WGM_UP 4
#endif
#ifndef WGM_OUT
#define WGM_OUT 4
#endif
#ifndef WGM_DN
#define WGM_DN 4
#endif
#ifndef ALIGN_SWIGLU
#define ALIGN_SWIGLU true
#endif
#ifndef ALIGN_QKV
#define ALIGN_QKV true
#endif
__global__ void __launch_bounds__(NWAVES * 64, 2) skel_fwd(Args args) {
    extern __shared__ __attribute__((aligned(16))) unsigned char lds[];
    Frame F;
    F.lds = (LAS unsigned char*)lds;
    F.MISC = (volatile LAS unsigned*)(F.lds + MISC_OFF);
    F.tid = threadIdx.x; F.lane = F.tid & 63; F.wave = __builtin_amdgcn_readfirstlane(F.tid >> 6);
    F.G = gridDim.x; { const int bx = blockIdx.x; F.vcu = (F.G % 8 == 0) ? (bx % 8) * (F.G / 8) + bx / 8 : bx; }
    unsigned char* ws = args.ws;
    F.ctl = (gu32*)(ws + WS_CTL);
    for (int u = F.tid; u < (LDS_BYTES - LDSCTL_OFF) / 4; u += NWAVES * 64) ((LAS unsigned*)(F.lds + LDSCTL_OFF))[u] = 0u;
    __syncthreads();
    XcdBarrier bar; bar.bar = (unsigned*)(F.ctl + CW_BAR); bar.x = 0; bar.st = nullptr;
    if (args.use_bar) bar = xcd_barrier_post((unsigned*)(F.ctl + CW_BAR), F.MISC + 8);
#if defined(PROBE_DOUBLE_BAR)
#define GRID_BAR() do { if (args.use_bar) { xcd_barrier(bar); xcd_barrier(bar); } } while (0)
#else
#define GRID_BAR() do { if (args.use_bar) xcd_barrier(bar); } while (0)
#endif
    const int lo = args.ph_lo, hi = args.ph_hi;
#ifndef PHASE_MASK
#define PHASE_MASK 0x7ff
#endif
#define IN(k) (((PHASE_MASK >> (k)) & 1) && lo <= (k) && (k) < hi)
#define BOTH(k) (IN(k) && IN((k) + 1))
#define NREP(k) (1 + ((REP_MASK >> (k)) & 1))
#define REPEAT(k) _Pragma("unroll") for (int rep = NREP(k) - 1; rep >= 0; --rep)
    bf16* wb = (bf16*)(ws + WS_W);
    float* ssq = (float*)(ws + WS_SSQ);
    bf16* xb = (bf16*)(ws + WS_XB); bf16* big = (bf16*)(ws + WS_BIG); bf16* mix = (bf16*)(ws + WS_MIX);
    const int G = F.G, cid = (int)blockIdx.x;

    if (IN(0)) { REPEAT(0) { p0_prologue(F, args); __syncthreads(); } if (BOTH(0)) GRID_BAR(); }
    if (IN(1)) {
        REPEAT(1) {
        cumsum_phase(F, args);
        pg8::Gemm g{xb, (const bf16*)((const char*)wb + WO_IN), M, N_IN, DM}; pg8::StaticOrder S; S.init(M, N_IN, G, cid, WGM_P1);
        pg8::EpiQKV<0> E{big, N_IN, ssq, (const float*)(ws + WS_GT), F.lds};
        pg8::gemm_phase<pg8::EpiQKV<0>, pg8::StaticOrder, ALIGN_QKV, true>(F.lds + RING_OFF, g, S, E);
        }
        if (BOTH(1)) GRID_BAR();
    }
    if (IN(2)) {
#if defined(PROBE_IMBAL)
#define IMB_BEGIN() unsigned long long tb_; asm volatile("s_memtime %0\n\ts_waitcnt lgkmcnt(0)" : "=s"(tb_) :: "memory")
#define IMB_END() do { __syncthreads(); unsigned long long te_; asm volatile("s_memtime %0\n\ts_waitcnt lgkmcnt(0)" : "=s"(te_) :: "memory"); if (F.tid == 0) { const unsigned d_ = (unsigned)(te_ - tb_); atomicMax((unsigned*)(F.ctl + 20000), d_); atomicAdd((unsigned*)(F.ctl + 20064), d_); } } while (0)
#else
#define IMB_BEGIN() do {} while (0)
#define IMB_END() do {} while (0)
#endif
        REPEAT(2) {
#if defined(PROBE_IMBAL) && PROBE_IMBAL == 1
            { IMB_BEGIN(); att::attn0_fox(F, args); IMB_END(); } att::attn0_diff(F, args);
#elif defined(PROBE_IMBAL) && PROBE_IMBAL == 2
            att::attn0_fox(F, args); { IMB_BEGIN(); att::attn0_diff(F, args); IMB_END(); }
#else
            REPEAT(11) att::attn0_fox(F, args); REPEAT(12) att::attn0_diff(F, args);
#endif
        }
        if (BOTH(2)) GRID_BAR();
    }
    if (IN(3)) {
        REPEAT(3) {
        pg8::Gemm g{mix, (const bf16*)((const char*)wb + WO_EO), M, DM, DM}; pg8::StaticOrder S; S.init(M, DM, G, cid, WGM_OUT);
#if defined(NULL_EPI_PROBE3)
        if (rep) { pg8::EpiNull E0; pg8::gemm_phase<pg8::EpiNull, pg8::StaticOrder, true, true>(F.lds + RING_OFF, g, S, E0); } else
#endif
        { pg8::EpiRes<false> E{xb, rep ? (bf16*)(ws + WS_R1) : xb, nullptr, rep ? ssq + 16 * M : ssq + 4 * M, (LAS float*)(F.lds + RING_BYTES)};
        pg8::gemm_phase<pg8::EpiRes<false>, pg8::StaticOrder, true, true>(F.lds + RING_OFF, g, S, E); }
        }
        if (BOTH(3)) GRID_BAR();
    }
    if (IN(4)) {
        REPEAT(4) {
        pg8::Gemm g{xb, (const bf16*)((const char*)wb + WO_UP0), M, N_UP, DM}; pg8::StaticOrder S; S.init(M, N_UP, G, cid, WGM_UP);
#if defined(NULL_EPI_PROBE)
        if (rep) { pg8::EpiNull E0; pg8::gemm_phase<pg8::EpiNull, pg8::StaticOrder, true, true>(F.lds + RING_OFF, g, S, E0); } else
#endif
        { pg8::EpiSwiGLU E{big, FFH, ssq + 4 * M, F.lds};
        if (G == 256) { pg8::StaticOrderRev<11> SR; SR.init(M, N_UP, G, cid, WGM_UP); pg8::gemm_phase<pg8::EpiSwiGLU, pg8::StaticOrderRev<11>, ALIGN_SWIGLU, true>(F.lds + RING_OFF, g, SR, E); }
        else pg8::gemm_phase<pg8::EpiSwiGLU, pg8::StaticOrder, ALIGN_SWIGLU, true>(F.lds + RING_OFF, g, S, E); }
        }
        if (BOTH(4)) GRID_BAR();
    }
    if (IN(5)) {
        REPEAT(5) {
        pg8::Gemm g{big, (const bf16*)((const char*)wb + WO_DN0), M, DM, FFH}; pg8::StaticOrder S; S.init(M, DM, G, cid, WGM_DN);
        pg8::EpiRes<false, true> E{xb, rep ? (bf16*)(ws + WS_R1) : xb, nullptr, rep ? ssq + 16 * M : ssq + 8 * M, (LAS float*)(F.lds + RING_BYTES)};
        if (G == 256) { pg8::StaticOrderRev<2> SR; SR.init(M, DM, G, cid, WGM_DN); pg8::gemm_phase<pg8::EpiRes<false, true>, pg8::StaticOrderRev<2>, true, true>(F.lds + RING_OFF, g, SR, E); }
        else pg8::gemm_phase<pg8::EpiRes<false, true>, pg8::StaticOrder, true, true>(F.lds + RING_OFF, g, S, E);
        }
        if (BOTH(5)) GRID_BAR();
    }
    if (IN(6)) {
        REPEAT(6) {
        pg8::Gemm g{xb, (const bf16*)((const char*)wb + WO_QKV), M, N_QKV, DM}; pg8::StaticOrder S; S.init(M, N_QKV, G, cid, WGM_P6);
        pg8::EpiQKV<1> E{big, N_QKV, ssq + 8 * M, (const float*)(ws + WS_GT) + 12 * 64, F.lds};
        pg8::gemm_phase<pg8::EpiQKV<1>, pg8::StaticOrder, ALIGN_QKV, true>(F.lds + RING_OFF, g, S, E);
        }
        if (BOTH(6)) GRID_BAR();
    }
    if (IN(7)) {
#if defined(PROBE_IMBAL) && PROBE_IMBAL == 3
        { IMB_BEGIN(); att::attn1_phase(F, args); IMB_END(); }
#else
        REPEAT(7) att::attn1_phase(F, args);
#endif
        if (BOTH(7)) GRID_BAR();
    }
    if (IN(8)) {
#if defined(PROBE_IMBAL)
        if (blockIdx.x == 0 && F.tid == 0) { const float mx_ = (float)__hip_atomic_load((unsigned*)(F.ctl + 20000), __ATOMIC_RELAXED, __HIP_MEMORY_SCOPE_AGENT), sm_ = (float)__hip_atomic_load((unsigned*)(F.ctl + 20064), __ATOMIC_RELAXED, __HIP_MEMORY_SCOPE_AGENT);
            ((float*)(ws + WS_GT))[2048] = 0.08f + 0.16f * (1.0f - sm_ / (mx_ * (float)gridDim.x)); }
#endif
        REPEAT(8) {
        pg8::Gemm g{mix, (const bf16*)((const char*)wb + WO_OO), M, DM, DM}; pg8::StaticOrder S; S.init(M, DM, G, cid, WGM_OUT);
        pg8::EpiRes<false> E{xb, rep ? (bf16*)(ws + WS_R1) : xb, nullptr, rep ? ssq + 16 * M : ssq + 12 * M, (LAS float*)(F.lds + RING_BYTES)};
        pg8::gemm_phase<pg8::EpiRes<false>, pg8::StaticOrder, true, true>(F.lds + RING_OFF, g, S, E);
        }
        if (BOTH(8)) GRID_BAR();
    }
    if (IN(9)) {
        REPEAT(9) {
        pg8::Gemm g{xb, (const bf16*)((const char*)wb + WO_UP1), M, N_UP, DM}; pg8::StaticOrder S; S.init(M, N_UP, G, cid, WGM_UP);
        pg8::EpiSwiGLU E{big, FFH, ssq + 12 * M, F.lds};
        if (G == 256) { pg8::StaticOrderRev<11> SR; SR.init(M, N_UP, G, cid, WGM_UP); pg8::gemm_phase<pg8::EpiSwiGLU, pg8::StaticOrderRev<11>, ALIGN_SWIGLU, true>(F.lds + RING_OFF, g, SR, E); }
        else pg8::gemm_phase<pg8::EpiSwiGLU, pg8::StaticOrder, ALIGN_SWIGLU, true>(F.lds + RING_OFF, g, S, E);
        }
        if (BOTH(9)) GRID_BAR();
    }
    if (IN(10)) {
        REPEAT(10) {
        pg8::Gemm g{big, (const bf16*)((const char*)wb + WO_DN1), M, DM, FFH}; pg8::StaticOrder S; S.init(M, DM, G, cid, WGM_DN);
        pg8::EpiRes<true, true> E{xb, nullptr, rep ? (float*)(ws + WS_R1) : args.out, (float*)(ws + WS_GT) + 2048, (LAS float*)(F.lds + RING_BYTES)};
        pg8::gemm_phase<pg8::EpiRes<true, true>, pg8::StaticOrder, true, true>(F.lds + RING_OFF, g, S, E);
        }
    }
#undef IN
#undef BOTH
#undef NREP
#undef REPEAT
#undef GRID_BAR
}

#if MK_MODE == 0
namespace simple {
constexpr int PP = N_IN;
__global__ __launch_bounds__(128) void fox_k(const bf16* __restrict__ proj, const float* __restrict__ c2, bf16* __restrict__ mix) {
    const int h = blockIdx.y, b = blockIdx.z, q0 = blockIdx.x * 128, qp = q0 + threadIdx.x;
    const size_t rb = (size_t)b * SEQ;
    const float* cc = c2 + (size_t)(b * 8 + h) * SEQ;
    float q[64], acc[64];
    const bf16* qr = proj + (rb + qp) * PP + h * 64;
#pragma unroll
    for (int d = 0; d < 64; ++d) { q[d] = bf2f(qr[d]); acc[d] = 0.f; }
    float m = -1e30f, l = 0.f;
    const int kend = q0 + 128;
    for (int k = 0; k < kend; ++k) {
        const bf16* kr = proj + (rb + k) * PP + 512 + h * 64;
        const bf16* vr = proj + (rb + k) * PP + 1024 + h * 64;
        float s = 0.f;
#pragma unroll
        for (int d = 0; d < 64; ++d) s = fmaf(q[d], bf2f(kr[d]), s);
        s -= cc[k];
        if (k <= qp) {
            const float mn = fmaxf(m, s);
            const float corr = exp2f(m - mn), p = exp2f(s - mn);
            l = l * corr + p;
#pragma unroll
            for (int d = 0; d < 64; ++d) acc[d] = fmaf(acc[d], corr, p * bf2f(vr[d]));
            m = mn;
        }
    }
    const float il = 1.0f / l;
    bf16* o = mix + (rb + qp) * DM + h * 64;
#pragma unroll
    for (int d = 0; d < 64; ++d) o[d] = (bf16)f2bf(acc[d] * il);
}
__global__ __launch_bounds__(256) void diff_k(const bf16* __restrict__ proj, const float* __restrict__ table, float* __restrict__ dtmp) {
    __shared__ float lut[129];
    const int h = blockIdx.y, b = blockIdx.z, q0 = blockIdx.x * 64;
    if (threadIdx.x < 128) lut[threadIdx.x] = table[kBucket[threadIdx.x] * 16 + h] * LOG2E_F;
    if (threadIdx.x == 128) lut[128] = table[31 * 16 + h] * LOG2E_F;
    __syncthreads();
    const size_t rb = (size_t)b * SEQ;
    const int w = threadIdx.x >> 6, lane = threadIdx.x & 63, m_ = w >> 1, vh = w & 1, qp = q0 + lane;
    float q[64], acc[64];
    const bf16* qr = proj + (rb + qp) * PP + 1536 + h * 128 + m_ * 64;
#pragma unroll
    for (int d = 0; d < 64; ++d) { q[d] = bf2f(qr[d]); acc[d] = 0.f; }
    float m = -1e30f, l = 0.f;
    const int kend = q0 + 64;
    for (int k = 0; k < kend; ++k) {
        const bf16* kr = proj + (rb + k) * PP + 2048 + h * 128 + m_ * 64;
        const bf16* vr = proj + (rb + k) * PP + 2560 + h * 128 + vh * 64;
        float s = 0.f;
#pragma unroll
        for (int d = 0; d < 64; ++d) s = fmaf(q[d], bf2f(kr[d]), s);
        if (k <= qp) {
            const int dl = qp - k;
            s += lut[dl < 128 ? dl : 128];
            const float mn = fmaxf(m, s);
            const float corr = exp2f(m - mn), p = exp2f(s - mn);
            l = l * corr + p;
#pragma unroll
            for (int d = 0; d < 64; ++d) acc[d] = fmaf(acc[d], corr, p * bf2f(vr[d]));
            m = mn;
        }
    }
    const float il = 1.0f / l;
    float* o = dtmp + (size_t)m_ * M * 512 + (rb + qp) * 512 + h * 128 + vh * 64;
#pragma unroll
    for (int d = 0; d < 64; ++d) o[d] = acc[d] * il;
}
__global__ __launch_bounds__(256) void diff_combine_k(const float* __restrict__ dtmp, const float* __restrict__ lq1, const float* __restrict__ lk1, const float* __restrict__ lq2,
                                                      const float* __restrict__ lk2, const float* __restrict__ subln, bf16* __restrict__ mix, float lambda_init) {
    const int t = blockIdx.x * blockDim.x + threadIdx.x;
    if (t >= M * 4) return;
    const int row = t >> 2, h = t & 3;
    float s1 = 0.f, s2 = 0.f;
    for (int i = 0; i < 64; ++i) { s1 += lq1[i] * lk1[i]; s2 += lq2[i] * lk2[i]; }
    const float lam = expf(s1) - expf(s2) + lambda_init;
    const float* o0 = dtmp + (size_t)row * 512 + h * 128;
    const float* o1 = dtmp + (size_t)M * 512 + (size_t)row * 512 + h * 128;
    float ss = 0.f;
    for (int e = 0; e < 128; ++e) { const float d = o0[e] - lam * o1[e]; ss += d * d; }
    const float r = rsqrtf(ss * (1.0f / 128.0f) + 1e-6f);
    bf16* o = mix + (size_t)row * DM + 512 + h * 128;
    for (int e = 0; e < 128; ++e) { const float d = o0[e] - lam * o1[e]; o[e] = (bf16)f2bf(d * r * subln[e] * (1.0f - lambda_init)); }
}
__global__ __launch_bounds__(128) void swa_k(const bf16* __restrict__ qkv, const float* __restrict__ table, const float* __restrict__ sinks, bf16* __restrict__ mix) {
    __shared__ float lut[128];
    const int h = blockIdx.y, kvh = h >> 2, b = blockIdx.z, q0 = blockIdx.x * 128, qp = q0 + threadIdx.x;
    lut[threadIdx.x] = table[kBucket[threadIdx.x] * 16 + h] * LOG2E_F;
    __syncthreads();
    const size_t rb = (size_t)b * SEQ;
    float q[64], acc[64];
    const bf16* qr = qkv + (rb + qp) * N_QKV + h * 64;
#pragma unroll
    for (int d = 0; d < 64; ++d) { q[d] = bf2f(qr[d]); acc[d] = 0.f; }
    float m = sinks[h] * LOG2E_F, l = 1.0f;
    int kbeg = q0 - 127; if (kbeg < 0) kbeg = 0;
    const int kend = q0 + 128;
    for (int k = kbeg; k < kend; ++k) {
        const bf16* kr = qkv + (rb + k) * N_QKV + 1024 + kvh * 64;
        const bf16* vr = qkv + (rb + k) * N_QKV + 1280 + kvh * 64;
        float s = 0.f;
#pragma unroll
        for (int d = 0; d < 64; ++d) s = fmaf(q[d], bf2f(kr[d]), s);
        const int dl = qp - k;
        if (dl >= 0 && dl < 128) {
            s += lut[dl];
            const float mn = fmaxf(m, s);
            const float corr = exp2f(m - mn), p = exp2f(s - mn);
            l = l * corr + p;
#pragma unroll
            for (int d = 0; d < 64; ++d) acc[d] = fmaf(acc[d], corr, p * bf2f(vr[d]));
            m = mn;
        }
    }
    const float il = 1.0f / l;
    bf16* o = mix + (rb + qp) * DM + h * 64;
#pragma unroll
    for (int d = 0; d < 64; ++d) o[d] = (bf16)f2bf(acc[d] * il);
}
}
#endif

extern "C" void kernel_launch(void* const* d_in, const int* in_sizes, int n_in, void* d_out, int out_size, void* d_ws, size_t ws_size, hipStream_t stream) {
    static int grid = 0;
    if (grid == 0) {
        if (n_in != 25 || in_sizes[0] != M * DM || out_size != M * DM || ws_size < WS_END) { fprintf(stderr, "kernel_launch: unexpected shapes / workspace (%d inputs, ws %zu)\n", n_in, ws_size); grid = -1; return; }
        int dev = 0, cus = 0, per_cu = 0;
        if (hipGetDevice(&dev) != hipSuccess || hipDeviceGetAttribute(&cus, hipDeviceAttributeMultiprocessorCount, dev) != hipSuccess) { grid = -1; return; }
        if (hipFuncSetAttribute((const void*)skel_fwd, hipFuncAttributeMaxDynamicSharedMemorySize, LDS_BYTES) != hipSuccess) { grid = -1; return; }
        if (hipOccupancyMaxActiveBlocksPerMultiprocessor(&per_cu, (const void*)skel_fwd, NWAVES * 64, LDS_BYTES) != hipSuccess || per_cu < 1) { fprintf(stderr, "kernel_launch: occupancy query says %d workgroups per CU; nothing launched\n", per_cu); grid = -1; return; }
        (void)hipGetLastError();
        grid = cus;
    }
    if (grid < 0) return;
    (void)hipMemsetAsync((char*)d_ws + WS_CTL, 0, CTL_ZERO_BYTES, stream);
    Args a{};
    for (int i = 0; i < 25; ++i) a.in[i] = (const float*)d_in[i];
    a.out = (float*)d_out; a.ws = (unsigned char*)d_ws;
    a.rep_mask = REP_MASK;
    unsigned char* ws = (unsigned char*)d_ws;
    const float* const* in = a.in;
#if MK_MODE == 0
    a.use_bar = 0;
    auto run = [&](int lo, int hi) { a.ph_lo = lo; a.ph_hi = hi; hipLaunchKernelGGL(skel_fwd, dim3(grid), dim3(NWAVES * 64), LDS_BYTES, stream, a); };
    run(0, 1); run(1, 2);
    hipLaunchKernelGGL(simple::fox_k, dim3(SEQ / 128, 8, NB), dim3(128), 0, stream, (const bf16*)(ws + WS_BIG), (const float*)(ws + WS_C2), (bf16*)(ws + WS_MIX));
    hipLaunchKernelGGL(simple::diff_k, dim3(SEQ / 64, 4, NB), dim3(256), 0, stream, (const bf16*)(ws + WS_BIG), in[1], (float*)(ws + WS_R1));
    hipLaunchKernelGGL(simple::diff_combine_k, dim3(M * 4 / 256), dim3(256), 0, stream, (const float*)(ws + WS_R1), in[9], in[10], in[11], in[12], in[13], (bf16*)(ws + WS_MIX), 0.2f);
    run(3, 4); run(4, 5); run(5, 6); run(6, 7);
    hipLaunchKernelGGL(simple::swa_k, dim3(SEQ / 128, 16, NB), dim3(128), 0, stream, (const bf16*)(ws + WS_BIG), in[1], in[19], (bf16*)(ws + WS_MIX));
    run(8, 9); run(9, 10); run(10, 11);
#elif MK_MODE == 1
    a.use_bar = 0;
    for (int p = 0; p < 11; ++p) { a.ph_lo = p; a.ph_hi = p + 1; hipLaunchKernelGGL(skel_fwd, dim3(grid), dim3(NWAVES * 64), LDS_BYTES, stream, a); }
#else
    a.use_bar = 1; a.ph_lo = 0; a.ph_hi = 11;
    hipLaunchKernelGGL(skel_fwd, dim3(grid), dim3(NWAVES * 64), LDS_BYTES, stream, a);
#endif
}
```
